# Optimizing an MI355X kernel written in HIP

```python
import math
import jax, jax.numpy as jnp
from jax import lax
import numpy as np

D_MODEL = 2048
BATCH = 4
SEQ = 2048
DEPTH = 2

N_A = DEPTH // 2
N_B = DEPTH - N_A

M_HEADS = 8
M_QK_DIM = D_MODEL // 2 // M_HEADS
M_V_DIM = D_MODEL // M_HEADS
M_CHUNK = 64
GATE_SOFTCAP = 15.0
M_HQK = M_HEADS * M_QK_DIM
M_HV = M_HEADS * M_V_DIM
M_SPLITS = (M_HQK, 2 * M_HQK, 2 * M_HQK + M_HV, 2 * M_HQK + 2 * M_HV, 2 * M_HQK + 2 * M_HV + M_HEADS)
M_IN_COLS = 2 * M_HQK + 2 * M_HV + 2 * M_HEADS

A_HEADS = 8
A_QK_DIM = D_MODEL // (2 * A_HEADS)
A_V_DIM = 2 * A_QK_DIM
A_HQK = A_HEADS * 2 * A_QK_DIM
A_HV = A_HEADS * A_V_DIM
ROPE_DIM = A_QK_DIM // 4
ROPE_THETA = 500000.0
Q_BLOCK = 128

D_FF = ((8 * D_MODEL // 3 + 255) // 256) * 256
CONV_W = 3
EPS = 1e-6

kernel_name = "yoco_mlstm_diffattn_convffn"


def rms_norm(x, g):
    xf = x.astype(jnp.float32)
    y = xf * lax.rsqrt(jnp.mean(xf * xf, axis=-1, keepdims=True) + EPS)
    return (y * g.astype(jnp.float32)).astype(x.dtype)


def softcap(t):
    return GATE_SOFTCAP * jnp.tanh(t / GATE_SOFTCAP)


def mlstm_chunkwise(q, k, v, i_pre, log_f):
    B, H, S, Dk = q.shape
    Dv = v.shape[-1]
    L = M_CHUNK
    nc = S // L
    q = q * (Dk ** -0.5)

    def to_chunks(t):
        return jnp.moveaxis(t.reshape((B, H, nc, L) + t.shape[3:]), 2, 0)

    qc, kc, vc, ic, fc = (to_chunks(t) for t in (q, k, v, i_pre, log_f))
    causal = jnp.tril(jnp.ones((L, L), dtype=bool))

    def step(carry, inp):
        C, n, m = carry
        qb, kb, vb, ib, fb = inp
        b = jnp.cumsum(fb, axis=-1)
        dmat = b[..., :, None] - b[..., None, :] + ib[..., None, :]
        dmat = jnp.where(causal, dmat, -jnp.inf)
        inter = b + m[..., None]
        m_t = jnp.maximum(inter, jnp.max(dmat, axis=-1))
        w_inter = jnp.exp(inter - m_t)
        s = jnp.einsum('bhtd,bhsd->bhts', qb, kb) * jnp.exp(dmat - m_t[..., None])
        num = w_inter[..., None] * jnp.einsum('bhvd,bhtd->bhtv', C, qb) + jnp.einsum('bhts,bhsv->bhtv', s, vb)
        den = w_inter * jnp.einsum('bhd,bhtd->bht', n, qb) + jnp.sum(s, axis=-1)
        h = num / jnp.maximum(jnp.abs(den), jnp.exp(-m_t))[..., None]
        b_last = b[..., -1]
        g = b_last[..., None] - b + ib
        m_new = jnp.maximum(b_last + m, jnp.max(g, axis=-1))
        decay = jnp.exp(b_last + m - m_new)
        wg = jnp.exp(g - m_new[..., None])
        C_new = decay[..., None, None] * C + jnp.einsum('bhs,bhsv,bhsd->bhvd', wg, vb, kb)
        n_new = decay[..., None] * n + jnp.einsum('bhs,bhsd->bhd', wg, kb)
        return (C_new, n_new, m_new), h

    init = (jnp.zeros((B, H, Dv, Dk), jnp.float32),
            jnp.zeros((B, H, Dk), jnp.float32),
            jnp.zeros((B, H), jnp.float32))
    _, hc = lax.scan(step, init, (qc, kc, vc, ic, fc))
    return jnp.moveaxis(hc, 0, 2).reshape(B, H, S, Dv)


def mlstm_mixer(xn, w_in, b_igate, b_fgate, w_hnorm, w_out):
    B, S, _ = xn.shape
    proj = xn @ w_in
    q, k, v, o, ig, fg = jnp.split(proj, M_SPLITS, axis=-1)

    def heads(t, d):
        return t.reshape(B, S, M_HEADS, d).transpose(0, 2, 1, 3).astype(jnp.float32)

    q, k, v = heads(q, M_QK_DIM), heads(k, M_QK_DIM), heads(v, M_V_DIM)
    i_pre = softcap((ig + b_igate).astype(jnp.float32)).transpose(0, 2, 1)
    log_f = jax.nn.log_sigmoid(softcap((fg + b_fgate).astype(jnp.float32))).transpose(0, 2, 1)
    h = mlstm_chunkwise(q, k, v, i_pre, log_f)
    h = rms_norm(h.transpose(0, 2, 1, 3), w_hnorm).astype(xn.dtype)
    h = h.reshape(B, S, M_HV) * jax.nn.sigmoid(o)
    return h @ w_out


def rope_partial(x, pos):
    half = ROPE_DIM // 2
    inv_freq = ROPE_THETA ** (-jnp.arange(half, dtype=jnp.float32) / half)
    ang = pos.astype(jnp.float32)[..., None] * inv_freq
    cos = jnp.cos(ang)[:, :, None, :]
    sin = jnp.sin(ang)[:, :, None, :]
    x1 = x[..., :half].astype(jnp.float32)
    x2 = x[..., half:ROPE_DIM].astype(jnp.float32)
    rot = jnp.concatenate([x1 * cos - x2 * sin, x2 * cos + x1 * sin], axis=-1).astype(x.dtype)
    return jnp.concatenate([rot, x[..., ROPE_DIM:]], axis=-1)


def shared_kv(h, g_kv, w_kv, pos):
    B, S, _ = h.shape
    kv = rms_norm(h, g_kv) @ w_kv
    k, v = jnp.split(kv, (A_HQK,), axis=-1)
    k = rope_partial(k.reshape(B, S, 2 * A_HEADS, A_QK_DIM), pos).reshape(B, S, A_HEADS, 2, A_QK_DIM)
    v = v.reshape(B, S, A_HEADS, A_V_DIM)
    return k, v


def diff_attention(xn, k, v, pos, w_q, lam_q1, lam_k1, lam_q2, lam_k2, g_subln, w_o, lambda_init):
    B, S, _ = xn.shape
    q = rope_partial((xn @ w_q).reshape(B, S, 2 * A_HEADS, A_QK_DIM), pos)
    q = q.reshape(B, S, A_HEADS, 2, A_QK_DIM) * (A_QK_DIM ** -0.5)
    lam = (jnp.exp(jnp.sum(lam_q1.astype(jnp.float32) * lam_k1.astype(jnp.float32)))
           - jnp.exp(jnp.sum(lam_q2.astype(jnp.float32) * lam_k2.astype(jnp.float32))) + lambda_init)
    outs = []
    for start in range(0, S, Q_BLOCK):
        end = start + Q_BLOCK
        qb, kb, vb = q[:, start:end], k[:, :end], v[:, :end]
        s = jnp.einsum('bqhcd,bkhcd->bhcqk', qb, kb).astype(jnp.float32)
        mask = (start + jnp.arange(Q_BLOCK))[:, None] >= jnp.arange(end)[None, :]
        p = jax.nn.softmax(jnp.where(mask, s, -jnp.inf), axis=-1)
        pd = p[:, :, 0] - lam * p[:, :, 1]
        outs.append(jnp.einsum('bhqk,bkhv->bqhv', pd.astype(vb.dtype), vb))
    o = jnp.concatenate(outs, axis=1)
    o = rms_norm(o, g_subln) * (1.0 - lambda_init)
    return o.reshape(B, S, A_HV) @ w_o


def conv_ffn(xn, w_up, conv_w, conv_b, w_down):
    S = xn.shape[1]
    u = xn @ w_up
    up = jnp.pad(u, ((0, 0), (CONV_W - 1, 0), (0, 0)))
    c = conv_b + up[:, 0:S] * conv_w[0]
    for j in range(1, CONV_W):
        c = c + up[:, j:j + S] * conv_w[j]
    gate, val = jnp.split(c, 2, axis=-1)
    return (jax.nn.silu(gate) * val) @ w_down


def setup_inputs(seed: int = 0) -> dict:
    key = jax.random.key(seed)
    ks = jax.random.split(key, 32)
    f32 = jnp.float32
    nrm = lambda k, shape, scale: jax.random.normal(k, shape, f32) * scale
    gain = lambda k, shape: 1.0 + 0.05 * jax.random.normal(k, shape, f32)
    x = jax.random.normal(ks[0], (BATCH, SEQ, D_MODEL), f32)
    offset = jax.random.randint(ks[1], (BATCH, 1), 0, 4096, dtype=jnp.int32)
    positions = offset + jnp.arange(SEQ, dtype=jnp.int32)[None, :]
    fbias = jnp.linspace(3.0, 6.0, M_HEADS, dtype=f32)[None, :] + 0.1 * jax.random.normal(ks[5], (N_A, M_HEADS), f32)
    return {
        "x": x,
        "positions": positions,
        "a_norm": gain(ks[2], (N_A, D_MODEL)),
        "m_w_in": nrm(ks[3], (N_A, D_MODEL, M_IN_COLS), D_MODEL ** -0.5),
        "m_b_igate": nrm(ks[4], (N_A, M_HEADS), 0.1),
        "m_b_fgate": fbias,
        "m_w_hnorm": gain(ks[6], (N_A, M_HEADS, M_V_DIM)),
        "m_w_out": nrm(ks[7], (N_A, M_HV, D_MODEL), M_HV ** -0.5),
        "kv_norm": gain(ks[8], (D_MODEL,)),
        "w_kv": nrm(ks[9], (D_MODEL, A_HQK + A_HV), D_MODEL ** -0.5),
        "b_norm": gain(ks[10], (N_B, D_MODEL)),
        "w_q": nrm(ks[11], (N_B, D_MODEL, A_HQK), D_MODEL ** -0.5),
        "lam_q1": nrm(ks[12], (N_B, A_QK_DIM), 0.1),
        "lam_k1": nrm(ks[13], (N_B, A_QK_DIM), 0.1),
        "lam_q2": nrm(ks[14], (N_B, A_QK_DIM), 0.1),
        "lam_k2": nrm(ks[15], (N_B, A_QK_DIM), 0.1),
        "subln": gain(ks[16], (N_B, A_V_DIM)),
        "w_o": nrm(ks[17], (N_B, A_HV, D_MODEL), A_HV ** -0.5),
        "f_norm": gain(ks[18], (DEPTH, D_MODEL)),
        "w_up": nrm(ks[19], (DEPTH, D_MODEL, 2 * D_FF), D_MODEL ** -0.5),
        "conv_w": nrm(ks[20], (DEPTH, CONV_W, 2 * D_FF), CONV_W ** -0.5),
        "conv_b": nrm(ks[21], (DEPTH, 2 * D_FF), 0.01),
        "w_down": nrm(ks[22], (DEPTH, D_FF, D_MODEL), D_FF ** -0.5),
        "final_norm": gain(ks[23], (D_MODEL,)),
    }


def reference(x, positions, a_norm, m_w_in, m_b_igate, m_b_fgate, m_w_hnorm, m_w_out,
              kv_norm, w_kv, b_norm, w_q, lam_q1, lam_k1, lam_q2, lam_k2, subln, w_o,
              f_norm, w_up, conv_w, conv_b, w_down, final_norm):
    h = x
    k_sh = None
    v_sh = None
    for layer in range(DEPTH):
        if layer < N_A:
            h = h + mlstm_mixer(rms_norm(h, a_norm[layer]), m_w_in[layer], m_b_igate[layer],
                                m_b_fgate[layer], m_w_hnorm[layer], m_w_out[layer])
        else:
            j = layer - N_A
            if j == 0:
                k_sh, v_sh = shared_kv(h, kv_norm, w_kv, positions)
            lambda_init = 0.8 - 0.6 * math.exp(-0.3 * layer)
            h = h + diff_attention(rms_norm(h, b_norm[j]), k_sh, v_sh, positions, w_q[j],
                                   lam_q1[j], lam_k1[j], lam_q2[j], lam_k2[j], subln[j], w_o[j],
                                   lambda_init)
        h = h + conv_ffn(rms_norm(h, f_norm[layer]), w_up[layer], conv_w[layer], conv_b[layer], w_down[layer])
    return rms_norm(h, final_norm)
```

```cpp
#include <hip/hip_runtime.h>
#include <hip/hip_bf16.h>
#include <hip/hip_cooperative_groups.h>
#include <cstdio>
#include <cstdint>
#include <cmath>
namespace cg = cooperative_groups;
__device__ __forceinline__ int ltid() { int t = threadIdx.x; asm volatile("" : "+v"(t)); return t; }namespace pg8 {
#define PG8_LAS __attribute__((address_space(3)))
typedef unsigned short bf16_t;
typedef short bf16x8 __attribute__((ext_vector_type(8)));
typedef float f32x4 __attribute__((ext_vector_type(4)));
typedef unsigned u32x4 __attribute__((ext_vector_type(4)));
constexpr int BM = 256, BK = 64, HALF = 128, HTB = HALF * BK * 2  , STAGE_BYTES = 8 * HTB, NXCD = 8, WGM = 8;

__host__ __device__ __forceinline__ int lds_byte(int r, int c) { const int st = (r >> 4) * 2 + (c >> 5), rr = r & 15, cc = c & 31, ob = rr * 64 + cc * 2; return st * 1024 + (ob ^ (((ob >> 9) & 1) << 5)); }
__host__ __device__ __forceinline__ void stage_rc(int b, int& R, int& C) { const int st = b / 1024, sb = b % 1024, swz = sb ^ (((sb >> 9) & 1) << 5); R = (st >> 1) * 16 + swz / 64; C = (st & 1) * 32 + (swz % 64) / 2; }
__host__ __device__ __forceinline__ int perm32(int rho) { const int n = rho >> 4, i = rho & 15; return 8 * (i >> 2) + 4 * n + (i & 3); }

struct Unit { int pm, pn; };
struct Gemm { const bf16_t* A; const bf16_t* Bt; int M, N, K; };

struct StaticOrder {
    int nM, nN, nwg, G, c;
    __host__ __device__ void init(int M, int N, int G_, int c_) { nM = M / BM; nN = N / BM; nwg = nM * nN; G = G_; c = c_; }
    __host__ __device__ bool next(int i, Unit& u) const {
        const long L = (long)i * G + c; if (L >= nwg) return false;
        int wgid = (int)L; { const int q = nwg / NXCD, r = nwg % NXCD, xcd = wgid % NXCD, off = wgid / NXCD; wgid = (xcd < r ? xcd * (q + 1) : r * (q + 1) + (xcd - r) * q) + off; }
        const int nig = WGM * nN, gid = wgid / nig, fm = gid * WGM, gsz = (nM - fm) < WGM ? (nM - fm) : WGM;
        u.pm = fm + ((wgid % nig) % gsz); u.pn = (wgid % nig) / gsz; return true;
    }
    __device__ __forceinline__ void a_ready(const Unit&) const {}
    __device__ __forceinline__ void done(const Unit&) const {}
};
__device__ __forceinline__ unsigned cvt_pk_bf16(float lo, float hi) { unsigned r; asm volatile("v_cvt_pk_bf16_f32 %0, %1, %2" : "=v"(r) : "v"(lo), "v"(hi)); return r; }
struct MapOrder : StaticOrder {
    int split, off0, off1;
    __device__ __forceinline__ bool next(int i, Unit& u) const { if (!StaticOrder::next(i, u)) return false; u.pn += (u.pn < split) ? off0 : off1; return true; }
};
typedef unsigned u32x2 __attribute__((ext_vector_type(2)));
typedef float f32x2 __attribute__((ext_vector_type(2)));
__device__ __forceinline__ float rstd_of(float ss) { return rsqrtf(ss * (1.0f / 2048.0f) + 1e-6f); }
__device__ __forceinline__ float row_ss(const float* ssp, int row, int fq) {
    const f32x4 a = *(const f32x4*)(ssp + (size_t)row * 32 + fq * 8), b = *(const f32x4*)(ssp + (size_t)row * 32 + fq * 8 + 4);
    float s = ((a[0] + a[1]) + (a[2] + a[3])) + ((b[0] + b[1]) + (b[2] + b[3]));
    s += __shfl_xor(s, 16); s += __shfl_xor(s, 32); return s;
}
struct EpiScaleBf16 {
    static constexpr bool PERM = true, AFTER_DRAIN = false;
    bf16_t* O; int ldc; const float* ss; int nq; float qs;
    __device__ __forceinline__ void operator()(const f32x4 (&acc)[2][2][4][2], const Unit& u, int wr, int wc, int fr, int fq) const {
        const int row0 = u.pm * BM + wr * 64 + fr, col0 = u.pn * BM + wc * 32 + 8 * fq;
        const float sc = (u.pn < nq) ? qs : 1.f;
#pragma unroll
        for (int ai = 0; ai < 2; ++ai)
#pragma unroll
            for (int m = 0; m < 4; ++m) { const int row = row0 + ai * HALF + m * 16; const float rs = rstd_of(row_ss(ss, row, fq)) * sc; bf16_t* rowp = O + (size_t)row * ldc + col0;
#pragma unroll
                for (int bj = 0; bj < 2; ++bj) { const f32x4 v0 = acc[ai][bj][m][0] * rs, v1 = acc[ai][bj][m][1] * rs;
                    u32x4 w; w.x = cvt_pk_bf16(v0[0], v0[1]); w.y = cvt_pk_bf16(v0[2], v0[3]); w.z = cvt_pk_bf16(v1[0], v1[1]); w.w = cvt_pk_bf16(v1[2], v1[3]);
                    *(u32x4*)(rowp + bj * HALF) = w; } }
    }
};
struct EpiResid {
    static constexpr bool PERM = true, AFTER_DRAIN = false;
    const float* Rin; bf16_t* XB; float* ss;
    __device__ __forceinline__ void operator()(const f32x4 (&acc)[2][2][4][2], const Unit& u, int wr, int wc, int fr_in, int fq_in) const {
        int fr = fr_in, fq = fq_in; asm volatile("" : "+v"(fr), "+v"(fq));
        const int row0 = u.pm * BM + wr * 64 + fr, col0 = u.pn * BM + wc * 32 + 8 * fq;
#pragma unroll
        for (int ai = 0; ai < 2; ++ai) {
            u32x4 b[4][2];
#pragma unroll
            for (int m = 0; m < 4; ++m) { const size_t off = (size_t)(row0 + ai * HALF + m * 16) * 2048 + col0;
#pragma unroll
                for (int bj = 0; bj < 2; ++bj) b[m][bj] = *(const u32x4*)(XB + off + bj * HALF); }
#pragma unroll
            for (int m = 0; m < 4; ++m) { const int row = row0 + ai * HALF + m * 16; const size_t off = (size_t)row * 2048 + col0; float s = 0.f;
#pragma unroll
                for (int bj = 0; bj < 2; ++bj) { const u32x4 r = b[m][bj];
                    const f32x4 o0 = (f32x4){__uint_as_float(r.x << 16), __uint_as_float(r.x & 0xffff0000u), __uint_as_float(r.y << 16), __uint_as_float(r.y & 0xffff0000u)} + acc[ai][bj][m][0];
                    const f32x4 o1 = (f32x4){__uint_as_float(r.z << 16), __uint_as_float(r.z & 0xffff0000u), __uint_as_float(r.w << 16), __uint_as_float(r.w & 0xffff0000u)} + acc[ai][bj][m][1];
                    u32x4 w; w.x = cvt_pk_bf16(o0[0], o0[1]); w.y = cvt_pk_bf16(o0[2], o0[3]); w.z = cvt_pk_bf16(o1[0], o1[1]); w.w = cvt_pk_bf16(o1[2], o1[3]);
                    *(u32x4*)(XB + off + bj * HALF) = w;
                    s += ((o0[0] * o0[0] + o0[1] * o0[1]) + (o0[2] * o0[2] + o0[3] * o0[3])) + ((o1[0] * o1[0] + o1[1] * o1[1]) + (o1[2] * o1[2] + o1[3] * o1[3])); }
                s += __shfl_xor(s, 16); s += __shfl_xor(s, 32);
                if (fq == 0) ss[(size_t)row * 32 + u.pn * 4 + wc] = s; }
            asm volatile("" ::: "memory"); }
    }
};
struct EpiQKV {
    static constexpr bool PERM = false, AFTER_DRAIN = false;
    bf16_t* QH; const float* ss; const float* COS; const float* SIN;
    __device__ __forceinline__ void operator()(const f32x4 (&acc)[2][2][4][2], const Unit& u, int wr, int wc, int fr, int fq) const {
        const int kind = u.pn >> 3, hc0 = 2 * (u.pn & 7); const bool rope = (kind < 2) && (wc == 0);
        bf16_t* base = QH + (size_t)kind * ((size_t)8192 * 2048);
        const int row0 = u.pm * BM + wr * 64 + fr;
#pragma unroll
        for (int ai = 0; ai < 2; ++ai)
#pragma unroll
            for (int m = 0; m < 4; ++m) { const int row = row0 + ai * HALF + m * 16; const int b = row >> 11, s = row & 2047; const float rs = rstd_of(row_ss(ss, row, fq));
                f32x4 cs = (f32x4){1.f, 1.f, 1.f, 1.f}, sn = (f32x4){0.f, 0.f, 0.f, 0.f};
                if (rope) { cs = *(const f32x4*)(COS + (size_t)row * 16 + 4 * fq); sn = *(const f32x4*)(SIN + (size_t)row * 16 + 4 * fq); }
#pragma unroll
                for (int bj = 0; bj < 2; ++bj) { f32x4 v0 = acc[ai][bj][m][0] * rs, v1 = acc[ai][bj][m][1] * rs;
                    if (rope) { const f32x4 r0 = v0 * cs - v1 * sn, r1 = v1 * cs + v0 * sn; v0 = r0; v1 = r1; }
                    bf16_t* dst = base + ((size_t)(b * 16 + hc0 + bj) * 2048 + s) * 128 + wc * 32 + 4 * fq;
                    u32x2 w0, w1; w0.x = cvt_pk_bf16(v0[0], v0[1]); w0.y = cvt_pk_bf16(v0[2], v0[3]); w1.x = cvt_pk_bf16(v1[0], v1[1]); w1.y = cvt_pk_bf16(v1[2], v1[3]);
                    *(u32x2*)dst = w0; *(u32x2*)(dst + 16) = w1; } }
    }
};

struct EpiConvAct {
    static constexpr bool PERM = true, AFTER_DRAIN = false;
    bf16_t* ACT; bf16_t* USIDE; const float* ss; const float* cw; const float* cb;
    __device__ __forceinline__ void operator()(const f32x4 (&acc)[2][2][4][2], const Unit& u, int wr, int wc, int fr_in, int fq_in) const {
        int fr = fr_in, fq = fq_in; asm volatile("" : "+v"(fr), "+v"(fq));
        const int lane = fq * 16 + fr, f0 = 128 * u.pn + 32 * wc + 8 * fq;
        const int src1 = (lane & 48) | ((fr + 15) & 15), src2 = (lane & 48) | ((fr + 14) & 15);
        const int row0 = u.pm * BM + wr * 64 + fr;
        const bool side = (fr >= 14) || (fr < 2); const int slot = (fr >= 14) ? fr - 14 : fr + 2;
        u32x2 pk[2][2][4][2];
#pragma unroll
        for (int ai = 0; ai < 2; ++ai)
#pragma unroll
            for (int m = 0; m < 4; ++m) { const float rs = rstd_of(row_ss(ss, row0 + ai * HALF + m * 16, fq));
#pragma unroll
                for (int bj = 0; bj < 2; ++bj)
#pragma unroll
                    for (int n = 0; n < 2; ++n) { const f32x4 v = acc[ai][bj][m][n] * rs; pk[ai][bj][m][n].x = cvt_pk_bf16(v[0], v[1]); pk[ai][bj][m][n].y = cvt_pk_bf16(v[2], v[3]); } }
        __builtin_amdgcn_sched_barrier(0);
        const bool l15 = (fr == 15), l14 = (fr >= 14);
#define CV_ROR(x, n_) ((unsigned)__builtin_amdgcn_update_dpp(0, (int)(x), 0x120 + (n_), 0xF, 0xF, false))
#define CV_UNPK(w) ((f32x2){__uint_as_float((w) << 16), __uint_as_float((w) & 0xffff0000u)})
#pragma unroll
        for (int ai = 0; ai < 2; ++ai) { u32x4 ow4[4];
#pragma unroll
            for (int n = 0; n < 2; ++n) { const int f = f0 + 4 * n;
                const f32x4 wg0 = *(const f32x4*)(cw + f), wg1 = *(const f32x4*)(cw + 11264 + f), wg2 = *(const f32x4*)(cw + 22528 + f), bg = *(const f32x4*)(cb + f);
                const f32x4 wv0 = *(const f32x4*)(cw + 5632 + f), wv1 = *(const f32x4*)(cw + 11264 + 5632 + f), wv2 = *(const f32x4*)(cw + 22528 + 5632 + f), bv = *(const f32x4*)(cb + 5632 + f);
                u32x2 ow[4];
#pragma unroll
                for (int h = 0; h < 2; ++h) {
                    const f32x2 g0 = {wg0[2 * h], wg0[2 * h + 1]}, g1 = {wg1[2 * h], wg1[2 * h + 1]}, g2 = {wg2[2 * h], wg2[2 * h + 1]}, gb = {bg[2 * h], bg[2 * h + 1]};
                    const f32x2 v0 = {wv0[2 * h], wv0[2 * h + 1]}, v1 = {wv1[2 * h], wv1[2 * h + 1]}, v2 = {wv2[2 * h], wv2[2 * h + 1]}, vb = {bv[2 * h], bv[2 * h + 1]};
#pragma unroll
                    for (int m = 0; m < 4; ++m) { const int mp = m > 0 ? m - 1 : 0;
                        const unsigned Wg = h ? pk[ai][0][m][n].y : pk[ai][0][m][n].x, Wgp = h ? pk[ai][0][mp][n].y : pk[ai][0][mp][n].x;
                        const unsigned Wv = h ? pk[ai][1][m][n].y : pk[ai][1][m][n].x, Wvp = h ? pk[ai][1][mp][n].y : pk[ai][1][mp][n].x;
                        const unsigned s1g = CV_ROR(l15 ? Wgp : Wg, 1), s2g = CV_ROR(l14 ? Wgp : Wg, 2), s1v = CV_ROR(l15 ? Wvp : Wv, 1), s2v = CV_ROR(l14 ? Wvp : Wv, 2);
                        const f32x2 g = gb + g0 * CV_UNPK(s2g) + g1 * CV_UNPK(s1g) + g2 * CV_UNPK(Wg);
                        const f32x2 v = vb + v0 * CV_UNPK(s2v) + v1 * CV_UNPK(s1v) + v2 * CV_UNPK(Wv);
                        f32x2 r; r.x = __builtin_amdgcn_rcpf(1.f + __builtin_amdgcn_exp2f(g.x * -1.44269504f)); r.y = __builtin_amdgcn_rcpf(1.f + __builtin_amdgcn_exp2f(g.y * -1.44269504f));
                        const f32x2 o = g * r * v; const unsigned w = cvt_pk_bf16(o.x, o.y); if (h) ow[m].y = w; else ow[m].x = w; } }
#pragma unroll
                for (int m = 0; m < 4; ++m) { if (n == 0) { ow4[m].x = ow[m].x; ow4[m].y = ow[m].y; } else { ow4[m].z = ow[m].x; ow4[m].w = ow[m].y; } }
                if (side) { const int k = 4 * u.pm + 2 * ai + wr; bf16_t* sp = USIDE + (size_t)(k * 4 + slot) * 11264 + f;
                    *(u32x2*)sp = (fr >= 8) ? pk[ai][0][3][n] : pk[ai][0][0][n]; *(u32x2*)(sp + 5632) = (fr >= 8) ? pk[ai][1][3][n] : pk[ai][1][0][n]; }
                __builtin_amdgcn_sched_barrier(0); }
#pragma unroll
            for (int m = 0; m < 4; ++m) { if (!(m == 0 && fr < 2)) *(u32x4*)(ACT + (size_t)(row0 + ai * HALF + m * 16) * 5632 + f0) = ow4[m]; }
            asm volatile("" ::: "memory"); }
#undef CV_ROR
#undef CV_UNPK
    }
};
template <class Epi, class Sched, bool ALIGN_EPI = false, bool SP2 = false>
__device__ __forceinline__ void gemm_phase(PG8_LAS unsigned char* lds, const Gemm g, const Sched& S, const Epi& E) {
    const int tid = ltid(), wid = __builtin_amdgcn_readfirstlane(tid >> 6), lane = tid & 63, wr = wid >> 2, wc = wid & 3, fr = lane & 15, fq = lane >> 4;
    const int K = g.K, nt = K / BK;
    unsigned voffA[2], voffB[2];
#pragma unroll
    for (int i = 0; i < 2; ++i) { int R, C; stage_rc(tid * 16 + i * 8192, R, C); const int Rb = Epi::PERM ? ((R & ~31) + perm32(R & 31)) : R;
        voffA[i] = (unsigned)(R * K + C) * 2u; voffB[i] = (unsigned)(Rb * K + C) * 2u; }
    const size_t kstep = (size_t)(BK * 2);
    const size_t hstep = (size_t)HALF * K * 2;
    const size_t tstep = 2 * hstep;
    const unsigned ldsw = (unsigned)wid * 1024u;
    const int aoff = lds_byte(wr * 64 + fr, fq * 8), boff = lds_byte(wc * 32 + fr, fq * 8);
#define PG8_SA(b, h) (((b) * 2 + (h)) * HTB)
#define PG8_SB(b, h) ((4 + (b) * 2 + (h)) * HTB)
#define PG8_STAGE(bufoff, gbase, voff) do { _Pragma("unroll") for (int _i = 0; _i < 2; ++_i) \
        __builtin_amdgcn_global_load_lds((const unsigned*)((const char*)(gbase) + (voff)[_i]), (PG8_LAS unsigned*)(lds + (bufoff) + ldsw + _i * 8192), 16, 0, 0); } while (0)
#define PG8_LDA(dst, b, h) do { _Pragma("unroll") for (int m = 0; m < 4; ++m) _Pragma("unroll") for (int k = 0; k < 2; ++k) dst[m][k] = *(const PG8_LAS bf16x8*)(lds + PG8_SA(b, h) + aoff + m * 2048 + k * 1024); } while (0)
#define PG8_LDB(dst, b, h) do { _Pragma("unroll") for (int n = 0; n < 2; ++n) _Pragma("unroll") for (int k = 0; k < 2; ++k) dst[n][k] = *(const PG8_LAS bf16x8*)(lds + PG8_SB(b, h) + boff + n * 2048 + k * 1024); } while (0)
#define PG8_MMA(ai, bj, At, Bt) do { __builtin_amdgcn_s_setprio(1); _Pragma("unroll") for (int m = 0; m < 4; ++m) _Pragma("unroll") for (int n = 0; n < 2; ++n) _Pragma("unroll") for (int k = 0; k < 2; ++k) \
        acc[ai][bj][m][n] = __builtin_amdgcn_mfma_f32_16x16x32_bf16(Bt[n][k], At[m][k], acc[ai][bj][m][n], 0, 0, 0); __builtin_amdgcn_s_setprio(0); } while (0)
#define PG8_WAIT_V(n) asm volatile("s_waitcnt vmcnt(" #n ")" ::: "memory")
#define PG8_WAIT_L(n) asm volatile("s_waitcnt lgkmcnt(" #n ")" ::: "memory")
#define PG8_BAR __builtin_amdgcn_s_barrier()
#define PG8_SCHED __builtin_amdgcn_sched_barrier(0)
    Unit cur, nxt; int ui = 0;
    if (!S.next(0, cur)) return;
    f32x4 acc[2][2][4][2];
#pragma unroll
    for (int a = 0; a < 2; ++a)
#pragma unroll
        for (int b = 0; b < 2; ++b)
#pragma unroll
            for (int m = 0; m < 4; ++m)
#pragma unroll
                for (int n = 0; n < 2; ++n) acc[a][b][m][n] = (f32x4){0.f, 0.f, 0.f, 0.f};
    bf16x8 At[4][2], B0[2][2], B1[2][2];
    const char* cA = (const char*)g.A + (size_t)cur.pm * tstep; const char* cB = (const char*)g.Bt + (size_t)cur.pn * tstep;
    S.a_ready(cur);
    if constexpr (SP2) {
        PG8_STAGE(PG8_SB(0, 0), cB, voffB); PG8_STAGE(PG8_SB(0, 1), cB + hstep, voffB); PG8_STAGE(PG8_SA(0, 0), cA, voffA); PG8_STAGE(PG8_SA(0, 1), cA + hstep, voffA);
        if (wr == 1) PG8_BAR;
        PG8_WAIT_V(2); PG8_BAR;
        PG8_STAGE(PG8_SB(1, 0), cB + kstep, voffB); PG8_STAGE(PG8_SA(1, 0), cA + kstep, voffA); PG8_STAGE(PG8_SB(1, 1), cB + hstep + kstep, voffB);
        PG8_WAIT_V(6); PG8_BAR;
    } else {
        PG8_STAGE(PG8_SB(0, 0), cB, voffB); PG8_STAGE(PG8_SA(0, 0), cA, voffA); PG8_STAGE(PG8_SB(0, 1), cB + hstep, voffB); PG8_STAGE(PG8_SA(0, 1), cA + hstep, voffA);
        if (wr == 1) PG8_BAR;
        PG8_WAIT_V(4); PG8_BAR;
        PG8_STAGE(PG8_SB(1, 0), cB + kstep, voffB); PG8_STAGE(PG8_SA(1, 0), cA + kstep, voffA); PG8_STAGE(PG8_SB(1, 1), cB + hstep + kstep, voffB);
        PG8_WAIT_V(6); PG8_BAR;
    }
    for (;;) {
        const bool has_next = S.next(ui + 1, nxt);
        const char* nA = has_next ? (const char*)g.A + (size_t)nxt.pm * tstep : cA; const char* nB = has_next ? (const char*)g.Bt + (size_t)nxt.pn * tstep : cB;
        for (int t = 0; t < nt; t += 2) {
            const bool last = (t == nt - 2);
            const char* a1 = cA + (size_t)(t + 1) * kstep;
            const char* a2 = last ? nA : cA + (size_t)(t + 2) * kstep; const char* b2 = last ? nB : cB + (size_t)(t + 2) * kstep;
            const char* a3 = a2 + kstep; const char* b3 = b2 + kstep;
            if (last && has_next) S.a_ready(nxt);
            if constexpr (SP2) {
            PG8_LDB(B0, 0, 0); PG8_LDB(B1, 0, 1); PG8_SCHED; PG8_LDA(At, 0, 0); PG8_STAGE(PG8_SA(1, 1), a1 + hstep, voffA);
            PG8_WAIT_V(8); PG8_WAIT_L(0); PG8_BAR; PG8_MMA(0, 0, At, B0); PG8_MMA(0, 1, At, B1); PG8_BAR; PG8_SCHED;
            PG8_LDA(At, 0, 1); PG8_STAGE(PG8_SB(0, 0), b2, voffB); PG8_STAGE(PG8_SB(0, 1), b2 + hstep, voffB); PG8_STAGE(PG8_SA(0, 0), a2, voffA);
            PG8_WAIT_V(8); PG8_WAIT_L(0); PG8_BAR; PG8_MMA(1, 0, At, B0); PG8_MMA(1, 1, At, B1); PG8_BAR; PG8_SCHED;
            PG8_LDB(B0, 1, 0); PG8_LDB(B1, 1, 1); PG8_SCHED; PG8_LDA(At, 1, 0); PG8_STAGE(PG8_SA(0, 1), a2 + hstep, voffA);
            PG8_WAIT_V(8); PG8_WAIT_L(0); PG8_BAR; PG8_MMA(0, 0, At, B0); PG8_MMA(0, 1, At, B1); PG8_BAR; PG8_SCHED;
            PG8_LDA(At, 1, 1); PG8_STAGE(PG8_SB(1, 0), b3, voffB); PG8_STAGE(PG8_SB(1, 1), b3 + hstep, voffB); PG8_STAGE(PG8_SA(1, 0), a3, voffA);
            PG8_WAIT_V(8); PG8_WAIT_L(0); PG8_BAR; PG8_MMA(1, 0, At, B0); PG8_MMA(1, 1, At, B1); PG8_BAR; PG8_SCHED;
            } else {
            PG8_LDB(B0, 0, 0); PG8_SCHED; PG8_LDA(At, 0, 0); PG8_STAGE(PG8_SA(1, 1), a1 + hstep, voffA);
            PG8_WAIT_L(8); PG8_BAR; PG8_WAIT_L(0); PG8_MMA(0, 0, At, B0); PG8_BAR; PG8_SCHED;
            PG8_LDB(B1, 0, 1); PG8_STAGE(PG8_SB(0, 0), b2, voffB);
            PG8_BAR; PG8_WAIT_L(0); PG8_MMA(0, 1, At, B1); PG8_BAR;
            PG8_LDA(At, 0, 1); PG8_STAGE(PG8_SA(0, 0), a2, voffA);
            PG8_BAR; PG8_WAIT_L(0); PG8_MMA(1, 0, At, B0); PG8_BAR; PG8_SCHED;
            PG8_STAGE(PG8_SB(0, 1), b2 + hstep, voffB);
            PG8_WAIT_V(6); PG8_BAR; PG8_MMA(1, 1, At, B1); PG8_BAR;
            PG8_LDB(B0, 1, 0); PG8_SCHED; PG8_LDA(At, 1, 0); PG8_STAGE(PG8_SA(0, 1), a2 + hstep, voffA);
            PG8_WAIT_L(8); PG8_BAR; PG8_WAIT_L(0); PG8_MMA(0, 0, At, B0); PG8_BAR; PG8_SCHED;
            PG8_LDB(B1, 1, 1); PG8_STAGE(PG8_SB(1, 0), b3, voffB);
            PG8_BAR; PG8_WAIT_L(0); PG8_MMA(0, 1, At, B1); PG8_BAR;
            PG8_LDA(At, 1, 1); PG8_STAGE(PG8_SA(1, 0), a3, voffA);
            PG8_BAR; PG8_WAIT_L(0); PG8_MMA(1, 0, At, B0); PG8_BAR; PG8_SCHED;
            PG8_STAGE(PG8_SB(1, 1), b3 + hstep, voffB);
            PG8_WAIT_V(6); PG8_BAR; PG8_MMA(1, 1, At, B1); PG8_BAR;
            }
        }
        if constexpr (ALIGN_EPI) { if (wr == 0) PG8_BAR; }
        if constexpr (!Epi::AFTER_DRAIN) { E(acc, cur, wr, wc, fr, fq); S.done(cur); }
        if (!has_next) break;
#pragma unroll
        for (int a = 0; a < 2; ++a)
#pragma unroll
            for (int b = 0; b < 2; ++b)
#pragma unroll
                for (int m = 0; m < 4; ++m)
#pragma unroll
                    for (int n = 0; n < 2; ++n) acc[a][b][m][n] = (f32x4){0.f, 0.f, 0.f, 0.f};
        cur = nxt; cA = nA; cB = nB; ++ui;
        if constexpr (ALIGN_EPI) { if (wr == 1) PG8_BAR; }
    }
    PG8_WAIT_V(0);
    if constexpr (!ALIGN_EPI) { if (wr == 0) PG8_BAR; }
    PG8_BAR;
    if constexpr (Epi::AFTER_DRAIN) { E.fused(acc, cur, wr, wc, fr, fq, lds, wid, lane); S.done(cur); }
#undef PG8_SA
#undef PG8_SB
#undef PG8_STAGE
#undef PG8_LDA
#undef PG8_LDB
#undef PG8_MMA
#undef PG8_WAIT_V
#undef PG8_WAIT_L
#undef PG8_BAR
#undef PG8_SCHED
}
}
namespace attn {
constexpr int D = 128; constexpr bool WSKIP = false; constexpr float THR = 8.f;
constexpr float SCALE = 0.08838834764831845f;
constexpr int NW = 8, QBLK = 32, KVBLK = 64, QB = NW * QBLK;
constexpr int SHM_V = KVBLK * D * 2, SHM_K = KVBLK * D * 2;
constexpr int LDS_BYTES = 2 * SHM_V + 2 * SHM_K + NW * 64 * 4;

using bf16 = __hip_bfloat16;
typedef short bf16x8 __attribute__((ext_vector_type(8)));
typedef short s16x4 __attribute__((ext_vector_type(4)));
typedef float f32x16 __attribute__((ext_vector_type(16)));
typedef float f32x4 __attribute__((ext_vector_type(4)));
typedef unsigned u32x4 __attribute__((ext_vector_type(4)));
template <class A, class Bt> struct same_t { static constexpr bool v = false; };
template <class A> struct same_t<A, A> { static constexpr bool v = true; };

#define KSWZ(row, colB) ((row) * 256 + ((colB) ^ (((row) & 7) << 4)))
#define SBAR() __builtin_amdgcn_sched_barrier(0)
__device__ __forceinline__ int v_st(int k, int c) { const int kk = (k & ~0xC) | ((k & 4) << 1) | ((k & 8) >> 1); return ((kk >> 3) * 4 + (c >> 5)) * 512 + ((kk & 7) * 32 + (c & 31)) * 2; }
__device__ __forceinline__ int v_rd_base(int lane) { return ((lane & 3) << 3) | (((lane >> 2) & 3) << 6) | (((lane >> 4) & 1) << 5) | (((lane >> 5) & 1) << 8); }
constexpr int v_rd_off(int d0, int ks, int half) { return d0 * 512 + ks * 4096 + half * 2048; }
__device__ __forceinline__ int crow(int r, int hi) { return (r & 3) + 8 * (r >> 2) + 4 * hi; }
__device__ __forceinline__ unsigned cvtpk(float lo, float hi) {
    unsigned r; asm volatile("v_cvt_pk_bf16_f32 %0, %1, %2" : "=v"(r) : "v"(lo), "v"(hi)); return r;
}
__device__ __forceinline__ bf16x8 pack8(f32x4 a, f32x4 b) {
    u32x4 w = {cvtpk(a[0], a[1]), cvtpk(a[2], a[3]), cvtpk(b[0], b[1]), cvtpk(b[2], b[3])};
    return *reinterpret_cast<bf16x8*>(&w);
}
template <class T> __device__ __forceinline__ bf16x8 load8(const T* p) {
    if constexpr (same_t<T, float>::v) { return pack8(*(const f32x4*)p, *(const f32x4*)(p + 4)); }
    else { return *reinterpret_cast<const bf16x8*>(p); }
}
__device__ __forceinline__ void mask_tile(f32x16& p0, f32x16& p1, int dq, unsigned W) {
    const float NEG = -__builtin_inff();
#pragma unroll
    for (int r = 0; r < 16; ++r) {
        const int c = (r & 3) + 8 * (r >> 2);
        if ((unsigned)(dq - c) >= W) p0[r] = NEG;
        if ((unsigned)(dq - c - 32) >= W) p1[r] = NEG;
    }
}
__device__ __forceinline__ void partialSM(f32x16& p0, f32x16& p1, float& m_reg, float& mn, float& alpha) {
    float pmax = p0[0]; for (int r = 1; r < 16; ++r) pmax = fmaxf(pmax, p0[r]); for (int r = 0; r < 16; ++r) pmax = fmaxf(pmax, p1[r]);
    { auto rr = __builtin_amdgcn_permlane32_swap(__float_as_uint(pmax), __float_as_uint(pmax), false, false);
      pmax = fmaxf(__uint_as_float(rr[0]), __uint_as_float(rr[1])); }
    constexpr float C2 = 1.4426950408889634f * SCALE;
    if (__builtin_expect(__all((pmax - m_reg) * SCALE <= THR), 1)) { mn = m_reg; alpha = 1.f; }
    else { mn = fmaxf(m_reg, pmax); alpha = __builtin_amdgcn_exp2f((m_reg - mn) * C2); m_reg = mn; }
    const float mnL = -mn * C2;
    for (int r = 0; r < 16; ++r) p0[r] = fmaf(p0[r], C2, mnL); for (int r = 0; r < 16; ++r) p1[r] = fmaf(p1[r], C2, mnL);
    for (int r = 0; r < 16; ++r) p0[r] = __builtin_amdgcn_exp2f(p0[r]);
}
__device__ __forceinline__ void finishSM(f32x16& p0, f32x16& p1, float alpha, float& l_reg, bf16x8& pa0, bf16x8& pa1, bf16x8& pa2, bf16x8& pa3) {
    for (int r = 0; r < 16; ++r) p1[r] = __builtin_amdgcn_exp2f(p1[r]);
    float ps = 0; for (int r = 0; r < 16; ++r) ps += p0[r]; for (int r = 0; r < 16; ++r) ps += p1[r];
    { auto rr = __builtin_amdgcn_permlane32_swap(__float_as_uint(ps), __float_as_uint(ps), false, false);
      ps = __uint_as_float(rr[0]) + __uint_as_float(rr[1]); }
    l_reg = l_reg * alpha + ps;
#define PK4(P, B_, OUT) do { unsigned a0 = cvtpk(P[B_+0], P[B_+1]), a1 = cvtpk(P[B_+2], P[B_+3]);                          \
        unsigned b0 = cvtpk(P[B_+4], P[B_+5]), b1 = cvtpk(P[B_+6], P[B_+7]);                                             \
        auto r0 = __builtin_amdgcn_permlane32_swap(a0, b0, false, false); auto r1 = __builtin_amdgcn_permlane32_swap(a1, b1, false, false); \
        u32x4 w = {r0[0], r1[0], r0[1], r1[1]}; OUT = *reinterpret_cast<bf16x8*>(&w); } while (0)
    PK4(p0, 0, pa0); PK4(p0, 8, pa1); PK4(p1, 0, pa2); PK4(p1, 8, pa3);
#undef PK4
}
template <int KB, bool SK>
__device__ __forceinline__ void qkt(f32x16& p0, f32x16& p1, const char* K_lds, int r32, int hi, const bf16x8* qr, bool act) {
    if (SK && !act) { const float NEG = -__builtin_inff();
#pragma unroll
        for (int r = 0; r < 16; ++r) { p0[r] = NEG; p1[r] = NEG; } return; }
    p0 = f32x16{}; p1 = f32x16{};
    const char* kb[4];
#pragma unroll
    for (int dd = 0; dd < 4; ++dd) kb[dd] = K_lds + KB * SHM_K + KSWZ(r32, (dd * 16 + hi * 8) * 2);
#pragma unroll
    for (int d0 = 0; d0 < 8; ++d0) { const char* a = kb[d0 & 3] + (d0 >> 2) * 128;
        bf16x8 b0 = *reinterpret_cast<const bf16x8*>(a);
        bf16x8 b1 = *reinterpret_cast<const bf16x8*>(a + 32 * 256);
        p0 = __builtin_amdgcn_mfma_f32_32x32x16_bf16(b0, qr[d0], p0, 0, 0, 0);
        p1 = __builtin_amdgcn_mfma_f32_32x32x16_bf16(b1, qr[d0], p1, 0, 0, 0); }
}
template <int VB, bool SK>
__device__ __forceinline__ void pv_tile(f32x16* o, int vb0, bf16x8 pa0, bf16x8 pa1, bf16x8 pa2, bf16x8 pa3, bool act) {
    if (SK && !act) return;
#define TRRD(dst, off) asm volatile("ds_read_b64_tr_b16 %0, %1 offset:%2" : "=&v"(dst) : "v"(vb0), "i"(off) : "memory")
#define PV_D0(d0) do { s16x4 l0, l1, l2, l3, h0, h1, h2, h3; constexpr int b_ = VB * SHM_V + v_rd_off(d0, 0, 0);     \
        TRRD(l0, b_); TRRD(h0, b_ + 2048); TRRD(l1, b_ + 4096); TRRD(h1, b_ + 6144); TRRD(l2, b_ + 8192); TRRD(h2, b_ + 10240); TRRD(l3, b_ + 12288); TRRD(h3, b_ + 14336); \
        asm volatile("s_waitcnt lgkmcnt(0)" ::: "memory"); SBAR();                 \
        o[d0] = __builtin_amdgcn_mfma_f32_32x32x16_bf16(pa0, (bf16x8){l0[0], l0[1], l0[2], l0[3], h0[0], h0[1], h0[2], h0[3]}, o[d0], 0, 0, 0);   \
        o[d0] = __builtin_amdgcn_mfma_f32_32x32x16_bf16(pa1, (bf16x8){l1[0], l1[1], l1[2], l1[3], h1[0], h1[1], h1[2], h1[3]}, o[d0], 0, 0, 0);   \
        o[d0] = __builtin_amdgcn_mfma_f32_32x32x16_bf16(pa2, (bf16x8){l2[0], l2[1], l2[2], l2[3], h2[0], h2[1], h2[2], h2[3]}, o[d0], 0, 0, 0);   \
        o[d0] = __builtin_amdgcn_mfma_f32_32x32x16_bf16(pa3, (bf16x8){l3[0], l3[1], l3[2], l3[3], h3[0], h3[1], h3[2], h3[3]}, o[d0], 0, 0, 0); } while (0)
    PV_D0(0); PV_D0(1); PV_D0(2); PV_D0(3);
#undef PV_D0
#undef TRRD
}

template <class TIn, class TOut> struct BlockRef { const TIn* Q; const TIn* K; const TIn* V; TOut* O; int P0; };
template <class TIn> struct Seam {
    bf16x8 qr[8];
    bf16x8 st_v0, st_v1, st_k0, st_k1; f32x4 sf0, sf1, sf2, sf3;
    f32x4 tq[16];
};
__device__ __forceinline__ int swa_jlo(int P0, int W) { const int lowk = P0 - W + 1; return lowk > 0 ? lowk / KVBLK : 0; }
#define ROW(p, k0, rr) ((p) + (size_t)((k0) + (rr)) * D + sc)
#define VMW() asm volatile("s_waitcnt vmcnt(0)" ::: "memory")
#define VMWN(n) asm volatile("s_waitcnt vmcnt(%0)" :: "i"(n) : "memory")
#define SLOAD_H(Kp, Vp, k0) do { S.st_v0 = load8<TIn>(ROW(Vp, k0, sr)); S.st_v1 = load8<TIn>(ROW(Vp, k0, 32 + sr));              \
                         S.st_k0 = load8<TIn>(ROW(Kp, k0, sr)); S.st_k1 = load8<TIn>(ROW(Kp, k0, 32 + sr)); } while (0)
#define SWRITE_HK(bf) do { *(bf16x8*)(K_lds + (bf) * SHM_K + kws) = S.st_k0; *(bf16x8*)(K_lds + (bf) * SHM_K + kws + 32 * 256) = S.st_k1; } while (0)
#define SWRITE_HV(bf) do { *(bf16x8*)(V_lds + (bf) * SHM_V + vst0) = S.st_v0; *(bf16x8*)(V_lds + (bf) * SHM_V + vst1) = S.st_v1; } while (0)
#define SWRITE_H(bf) do { SWRITE_HV(bf); SWRITE_HK(bf); } while (0)
#define SLOAD_F(p, k0) do { S.sf0 = *(const f32x4*)ROW(p, k0, sr); S.sf1 = *(const f32x4*)(ROW(p, k0, sr) + 4);                \
                            S.sf2 = *(const f32x4*)ROW(p, k0, 32 + sr); S.sf3 = *(const f32x4*)(ROW(p, k0, 32 + sr) + 4); } while (0)
#define SWRITE_KF(bf) do { *(bf16x8*)(K_lds + (bf) * SHM_K + kws) = pack8(S.sf0, S.sf1); *(bf16x8*)(K_lds + (bf) * SHM_K + kws + 32 * 256) = pack8(S.sf2, S.sf3); } while (0)
#define SWRITE_VF(bf) do { *(bf16x8*)(V_lds + (bf) * SHM_V + vst0) = pack8(S.sf0, S.sf1); *(bf16x8*)(V_lds + (bf) * SHM_V + vst1) = pack8(S.sf2, S.sf3); } while (0)
template <class TIn, class TOut>
__device__ __forceinline__ void causal_swa_prime(const BlockRef<TIn, TOut>& cur, int W, char* lds, Seam<TIn>& S) {
    constexpr bool F32 = same_t<TIn, float>::v;
    const int tid = ltid(), wid = __builtin_amdgcn_readfirstlane(tid >> 6), lane = tid & 63, r32 = lane & 31, hi = lane >> 5;
    const int sr = tid >> 4, sc = (tid & 15) * 8, kws = KSWZ(sr, sc * 2); char* K_lds = lds + 2 * SHM_V;
    const int kb0 = swa_jlo(cur.P0, W) * KVBLK;
    for (int d0 = 0; d0 < 8; ++d0) S.qr[d0] = load8<TIn>(cur.Q + (size_t)(wid * QBLK + r32) * D + d0 * 16 + hi * 8);
    if constexpr (F32) { SLOAD_F((const float*)cur.K, kb0); VMW(); SWRITE_KF(0); SBAR(); SLOAD_F((const float*)cur.V, kb0); }
    else { SLOAD_H(cur.K, cur.V, kb0); VMW(); SWRITE_HK(0); }
    __syncthreads();
}
template <class TIn, class TOut>
__device__ __forceinline__ void causal_swa_block(const BlockRef<TIn, TOut>& cur, const BlockRef<TIn, TOut>& nxt, int skv, int W, char* lds, Seam<TIn>& S) {
    constexpr bool F32 = same_t<TIn, float>::v;
    const int tid = ltid(), wid = __builtin_amdgcn_readfirstlane(tid >> 6), lane = tid & 63, r32 = lane & 31, hi = lane >> 5;
    const int j_lo = swa_jlo(cur.P0, W);
    int j_hi = (cur.P0 + QB - 1) / KVBLK + 1; if (j_hi > skv / KVBLK) j_hi = skv / KVBLK;
    const int NT = j_hi - j_lo;
    const int kbn = swa_jlo(nxt.P0, W) * KVBLK;
    const int qlo = cur.P0 + wid * QBLK, qm = qlo + r32 - 4 * hi;
    char* V_lds = lds; char* K_lds = lds + 2 * SHM_V;
    float* ws = (float*)(lds + 2 * SHM_V + 2 * SHM_K) + wid * 64; float* li_l = ws, * al_l = ws + 32;
    float m_reg = -1e30f, l_reg = 0; f32x16 o[4] = {};
    const int sr = tid >> 4, sc = (tid & 15) * 8, vst0 = v_st(sr, sc), vst1 = v_st(32 + sr, sc), kws = KSWZ(sr, sc * 2);
    const int vb0 = (int)(uintptr_t)V_lds + v_rd_base(lane);
    const TIn* Kh = cur.K; const TIn* Vh = cur.V;
#define RESC(a) do { if (__any((a) < 1.f)) { if (hi == 0) al_l[r32] = (a); asm volatile("s_waitcnt lgkmcnt(0)" ::: "memory");              \
                     for (int d_ = 0; d_ < 4; ++d_) for (int r = 0; r < 16; ++r) o[d_][r] *= al_l[crow(r, hi)]; } } while (0)
#define KBASE(t) ((j_lo + (t)) * KVBLK)
#define ACT(t) (KBASE(t) <= qlo + QBLK - 1 && KBASE(t) + KVBLK - 1 >= qlo - W + 1)
#define MASKT(P0_, P1_, t) do { const int kb_ = KBASE(t); if ((!SK || ACT(t)) && (kb_ + KVBLK - 1 > qlo || kb_ <= qlo + QBLK - 1 - W)) mask_tile(P0_, P1_, qm - kb_, (unsigned)W); } while (0)
    constexpr int NQL = F32 ? 16 : 8;
    constexpr bool SK = WSKIP && !F32;
#define SEAM_K0() do { VMWN(NQL); if constexpr (F32) { SWRITE_KF(0); SBAR(); SLOAD_F((const float*)nxt.V, kbn); } else { SWRITE_HK(0); } SBAR(); } while (0)
    f32x16 pA0, pA1, pB0, pB1; float mnA, mnB, alA, alB; bf16x8 pa0, pa1, pa2, pa3;
    if constexpr (F32) { VMW(); SWRITE_VF(0); SBAR(); } else { SWRITE_HV(0); SBAR(); }
    if (NT > 1) { if constexpr (F32) SLOAD_F((const float*)Kh, KBASE(1)); else SLOAD_H(Kh, Vh, KBASE(1)); }
    SBAR(); qkt<0, SK>(pA0, pA1, K_lds, r32, hi, S.qr, ACT(0));
    if constexpr (F32) { if (NT > 1) { VMW(); SWRITE_KF(1); SBAR(); SLOAD_F((const float*)Vh, KBASE(1)); } }
    MASKT(pA0, pA1, 0); partialSM(pA0, pA1, m_reg, mnA, alA);
    if (NT > 1) { VMW(); if constexpr (F32) { SWRITE_VF(1); SBAR(); if (NT > 2) SLOAD_F((const float*)Kh, KBASE(2)); } else SWRITE_H(1); }
    __syncthreads();
#define HALF_STEP(PX0, PX1, mnX, alX, PY0, PY1, alY, t, KB, VB, SB) do {                                                      \
        SBAR(); qkt<KB, SK>(PX0, PX1, K_lds, r32, hi, S.qr, ACT(t));                                             \
        finishSM(PY0, PY1, alY, l_reg, pa0, pa1, pa2, pa3); SBAR();                                                           \
        if ((t) + 1 < NT) { if constexpr (F32) { VMW(); SWRITE_KF(SB); SBAR(); SLOAD_F((const float*)Vh, KBASE((t) + 1)); }  \
                            else { SLOAD_H(Kh, Vh, KBASE((t) + 1)); } SBAR(); }                                               \
        pv_tile<VB, SK>(o, vb0, pa0, pa1, pa2, pa3, ACT((t) - 1)); MASKT(PX0, PX1, (t)); partialSM(PX0, PX1, m_reg, mnX, alX);                                        \
        __syncthreads();                                                                                                      \
        if ((t) + 1 < NT) { VMW(); if constexpr (F32) { SWRITE_VF(SB); SBAR(); if ((t) + 2 < NT) SLOAD_F((const float*)Kh, KBASE((t) + 2)); } \
                            else { SWRITE_H(SB); } }                                                                          \
        RESC(alX); __syncthreads(); } while (0)
    for (int t = 1; t + 1 < NT; t += 2) {
        HALF_STEP(pB0, pB1, mnB, alB, pA0, pA1, alA, t, 1, 0, 0);
        HALF_STEP(pA0, pA1, mnA, alA, pB0, pB1, alB, t + 1, 0, 1, 1);
    }
    const bool even = (NT & 1) == 0;
    if (even) { SBAR(); qkt<1, SK>(pB0, pB1, K_lds, r32, hi, S.qr, ACT(NT - 1)); SBAR(); }
#define QROW(e) (nxt.Q + (size_t)(wid * QBLK + r32) * D + ((e) >> 1) * 16 + hi * 8 + ((e) & 1) * 4)
    if constexpr (F32) { SLOAD_F((const float*)nxt.K, kbn); SBAR();
#pragma unroll
        for (int e = 0; e < 8; ++e) S.tq[e] = *(const f32x4*)QROW(e); }
    else { SLOAD_H(nxt.K, nxt.V, kbn); SBAR();
#pragma unroll
        for (int d0 = 0; d0 < 8; ++d0) S.qr[d0] = load8<TIn>(nxt.Q + (size_t)(wid * QBLK + r32) * D + d0 * 16 + hi * 8); }
    SBAR();
    finishSM(pA0, pA1, alA, l_reg, pa0, pa1, pa2, pa3); SBAR();
    if constexpr (F32) {
#pragma unroll
        for (int e = 8; e < 16; ++e) S.tq[e] = *(const f32x4*)QROW(e); SBAR(); }
#undef QROW
    pv_tile<0, SK>(o, vb0, pa0, pa1, pa2, pa3, ACT(even ? NT - 2 : NT - 1));
    if (even) { MASKT(pB0, pB1, NT - 1); partialSM(pB0, pB1, m_reg, mnB, alB); __syncthreads(); RESC(alB);
        finishSM(pB0, pB1, alB, l_reg, pa0, pa1, pa2, pa3); SBAR(); pv_tile<1, SK>(o, vb0, pa0, pa1, pa2, pa3, ACT(NT - 1)); }
    SBAR(); SEAM_K0();
    if (hi == 0) li_l[r32] = l_reg; asm volatile("s_waitcnt lgkmcnt(0)" ::: "memory");
    float rli[16];
#pragma unroll
    for (int r = 0; r < 16; ++r) rli[r] = __builtin_amdgcn_rcpf(li_l[crow(r, hi)]);
    TOut* Ow = cur.O + (size_t)(wid * QBLK) * D;
#pragma unroll
    for (int r = 0; r < 16; ++r) { const int orow = crow(r, hi);
#pragma unroll
        for (int d0 = 0; d0 < 4; ++d0) { const float v = o[d0][r] * rli[r];
            if constexpr (same_t<TOut, float>::v) { Ow[(size_t)orow * D + d0 * 32 + r32] = v; }
            else { const float vn = __shfl_xor(v, 1);
                   if ((r32 & 1) == 0) *(unsigned*)(Ow + (size_t)orow * D + d0 * 32 + r32) = cvtpk(v, vn); } } }
    if constexpr (F32) {
#pragma unroll
        for (int d0 = 0; d0 < 8; ++d0) S.qr[d0] = pack8(S.tq[2 * d0], S.tq[2 * d0 + 1]); }
    __syncthreads();
#undef RESC
#undef KBASE
#undef ACT
#undef MASKT
#undef SEAM_K0
#undef HALF_STEP
}
#undef ROW
#undef VMW
#undef VMWN
#undef SLOAD_H
#undef SWRITE_HK
#undef SWRITE_HV
#undef SWRITE_H
#undef SLOAD_F
#undef SWRITE_KF
#undef SWRITE_VF
}
#define LAS __attribute__((address_space(3)))
typedef unsigned short bf16u;
typedef float f32x4 __attribute__((ext_vector_type(4)));
typedef unsigned u32x4 __attribute__((ext_vector_type(4)));
typedef unsigned u32x2 __attribute__((ext_vector_type(2)));
constexpr int MTOK = 8192, DM = 2048, SEQ = 2048, DFF = 5632, NWAVES = 8;
constexpr size_t MiB = (size_t)1 << 20;
constexpr size_t WS_SS = 0, WS_IG = 128 * 1024, WS_FG = 384 * 1024, WS_COS = 640 * 1024, WS_SIN = 1152 * 1024, WS_BAR = 1792 * 1024;
constexpr size_t WS_WIN = 2 * MiB, WS_WOUT = 26 * MiB, WS_WUP0 = 34 * MiB, WS_WDN0 = 78 * MiB, WS_WQKV = 100 * MiB, WS_WO = 124 * MiB, WS_WUP1 = 132 * MiB, WS_WDN1 = 176 * MiB;
constexpr size_t WS_XB = 198 * MiB, WS_R = 230 * MiB, WS_A = 294 * MiB, WS_U = 486 * MiB, WS_SSP = 662 * MiB, WS_END = 666 * MiB;
constexpr size_t WS_PROJ = WS_A, WS_HRAW = WS_A + 96 * MiB, WS_HN = WS_A + 160 * MiB;
constexpr size_t WS_QH = WS_A, WS_OH = WS_A + 96 * MiB, WS_ON = WS_A + 160 * MiB;
constexpr size_t WS_ACT = WS_A;
constexpr int LDS_BYTES = 144 * 1024, LDS_CTL = LDS_BYTES - 64;
constexpr float QSCALE = 0.08838834764831845f;
constexpr float LAMBDA_INIT = 0.35550906759f;

struct Args { const void* in[24]; float* out; unsigned char* ws; float invf[16]; };

__device__ __forceinline__ float wave_sum(float v) {
#pragma unroll
    for (int o = 1; o < 64; o <<= 1) v += __shfl_xor(v, o);
    return v;
}
__device__ __forceinline__ float bf2f(unsigned short b) { return __uint_as_float(((unsigned)b) << 16); }
__device__ __forceinline__ float bflo(unsigned w) { return __uint_as_float(w << 16); }
__device__ __forceinline__ float bfhi(unsigned w) { return __uint_as_float(w & 0xffff0000u); }
typedef float f32x2_t __attribute__((ext_vector_type(2)));
typedef __bf16 bf16x2_t __attribute__((ext_vector_type(2)));
__device__ __forceinline__ unsigned pk2(float lo, float hi) { f32x2_t v = {lo, hi}; bf16x2_t b = __builtin_convertvector(v, bf16x2_t); return __builtin_bit_cast(unsigned, b); }

__device__ __forceinline__ void transpose_item(const float* W, int ldw, int c0, const float* gain, bf16u* WT, int K, int row_off, int kb, int nb, int lane, int perm) {
    const int r = lane >> 4, c4 = lane & 15, k0 = 64 * kb + 16 * r, n0 = 64 * nb + 4 * c4;
    const float* src = W + (size_t)k0 * ldw + c0 + n0;
    f32x4 t[16];
#pragma unroll
    for (int i = 0; i < 16; ++i) t[i] = __builtin_nontemporal_load((const f32x4*)(src + (size_t)i * ldw));
    if (gain) {
#pragma unroll
        for (int q = 0; q < 4; ++q) { const f32x4 g = *(const f32x4*)(gain + k0 + 4 * q);
#pragma unroll
            for (int e = 0; e < 4; ++e) t[4 * q + e] = t[4 * q + e] * g[e]; } }
    int d0 = n0; if (perm) { const int bj = n0 >= 5632 ? 1 : 0, rem = n0 - bj * 5632; d0 = 256 * (rem >> 7) + 128 * bj + (rem & 127); }
#pragma unroll
    for (int e = 0; e < 4; ++e) { bf16u* dst = WT + (size_t)(row_off + d0 + e) * K + k0;
        u32x4 o0, o1;
        o0.x = pk2(t[0][e], t[1][e]); o0.y = pk2(t[2][e], t[3][e]); o0.z = pk2(t[4][e], t[5][e]); o0.w = pk2(t[6][e], t[7][e]);
        o1.x = pk2(t[8][e], t[9][e]); o1.y = pk2(t[10][e], t[11][e]); o1.z = pk2(t[12][e], t[13][e]); o1.w = pk2(t[14][e], t[15][e]);
        *(u32x4*)dst = o0; *(u32x4*)(dst + 8) = o1; }
}

constexpr int CW_I0 = 3072, CW_I1 = 1024, CW_I2 = 5632, CW_I3 = 2816, CW_I4 = 1024, CW_I5 = 2048, CW_I6 = 1024, CW_I7 = 5632, CW_I8 = 2816;
constexpr int CW_MID = CW_I0, CW_EARLY = CW_I0 + CW_I1 + CW_I2 + CW_I3 + CW_I4 + CW_I5 + CW_I6, CW_ALL = CW_EARLY + CW_I7 + CW_I8;
__device__ __forceinline__ void convert_weights(const Args& a, int lo, int hi, int vw, int nvw, int lane) {
    unsigned char* ws = a.ws;
    for (int it = lo + vw; it < hi; it += nvw) {
        int r = it; const float* W; const float* gain; bf16u* WT; int ldw, c0 = 0, K = 2048, row_off = 0, nblk, perm = 0;
        if (r < CW_I0) { W = (const float*)a.in[3]; ldw = 6160; gain = (const float*)a.in[2]; WT = (bf16u*)(ws + WS_WIN); nblk = 96; }
        else if ((r -= CW_I0) < CW_I1) { W = (const float*)a.in[7]; ldw = 2048; gain = nullptr; WT = (bf16u*)(ws + WS_WOUT); nblk = 32; }
        else if ((r -= CW_I1) < CW_I2) { W = (const float*)a.in[19]; ldw = 11264; gain = (const float*)a.in[18]; WT = (bf16u*)(ws + WS_WUP0); nblk = 176; perm = 1; }
        else if ((r -= CW_I2) < CW_I3) { W = (const float*)a.in[22]; ldw = 2048; gain = nullptr; WT = (bf16u*)(ws + WS_WDN0); nblk = 32; K = 5632; }
        else if ((r -= CW_I3) < CW_I4) { W = (const float*)a.in[11]; ldw = 2048; gain = (const float*)a.in[10]; WT = (bf16u*)(ws + WS_WQKV); nblk = 32; }
        else if ((r -= CW_I4) < CW_I5) { W = (const float*)a.in[9]; ldw = 4096; gain = (const float*)a.in[8]; WT = (bf16u*)(ws + WS_WQKV); nblk = 64; row_off = 2048; }
        else if ((r -= CW_I5) < CW_I6) { W = (const float*)a.in[17]; ldw = 2048; gain = nullptr; WT = (bf16u*)(ws + WS_WO); nblk = 32; }
        else if ((r -= CW_I6) < CW_I7) { W = (const float*)a.in[19] + (size_t)2048 * 11264; ldw = 11264; gain = (const float*)a.in[18] + 2048; WT = (bf16u*)(ws + WS_WUP1); nblk = 176; perm = 1; }
        else { r -= CW_I7; W = (const float*)a.in[22] + (size_t)5632 * 2048; ldw = 2048; gain = nullptr; WT = (bf16u*)(ws + WS_WDN1); nblk = 32; K = 5632; }
        transpose_item(W, ldw, c0, gain, WT, K, row_off, r / nblk, r % nblk, lane, perm);
    }
}

__device__ __forceinline__ void p0_prologue(const Args& a, LAS unsigned char* lds) {
    const int tid = ltid(), lane = tid & 63, wave = __builtin_amdgcn_readfirstlane(tid >> 6);
    unsigned char* ws = a.ws;
    const float* x = (const float*)a.in[0]; const int* pos = (const int*)a.in[1];
    const float* a_norm = (const float*)a.in[2]; const float* w_in = (const float*)a.in[3];
    const float* b_ig = (const float*)a.in[4]; const float* b_fg = (const float*)a.in[5];
    const int gw = blockIdx.x * NWAVES + wave, NGW = gridDim.x * NWAVES;
    convert_weights(a, 0, CW_MID, gw, NGW, lane);
    __syncthreads();
    LAS float* G = (LAS float*)lds;
    for (int idx = tid; idx < 2048 * 16; idx += 512) { const int k = idx >> 4, j = idx & 15; G[j * 2048 + k] = a_norm[k] * w_in[(size_t)k * 6160 + 6144 + j]; }
    __syncthreads();
    float* SS0 = (float*)(ws + WS_SSP); float* IG = (float*)(ws + WS_IG); float* FG = (float*)(ws + WS_FG); float* COS = (float*)(ws + WS_COS); float* SIN = (float*)(ws + WS_SIN);
    bf16u* XB = (bf16u*)(ws + WS_XB);
    for (int rg = gw; rg < MTOK / 4; rg += NGW) {
        const int m0 = rg * 4;
        float acc[4][16]; float ssq[4];
#pragma unroll
        for (int r = 0; r < 4; ++r) { ssq[r] = 0.f;
#pragma unroll
            for (int j = 0; j < 16; ++j) acc[r][j] = 0.f; }
#pragma unroll 2
        for (int i = 0; i < 8; ++i) { const int k4 = lane + 64 * i; f32x4 xv[4];
#pragma unroll
            for (int r = 0; r < 4; ++r) { xv[r] = *(const f32x4*)(x + (size_t)(m0 + r) * DM + 4 * k4); ssq[r] += (xv[r][0] * xv[r][0] + xv[r][1] * xv[r][1]) + (xv[r][2] * xv[r][2] + xv[r][3] * xv[r][3]);
                u32x2 w; w.x = pk2(xv[r][0], xv[r][1]); w.y = pk2(xv[r][2], xv[r][3]); *(u32x2*)(XB + (size_t)(m0 + r) * DM + 4 * k4) = w; }
#pragma unroll
            for (int j = 0; j < 16; ++j) { const f32x4 g = *(const LAS f32x4*)(G + j * 2048 + 4 * k4);
#pragma unroll
                for (int r = 0; r < 4; ++r) acc[r][j] += (xv[r][0] * g[0] + xv[r][1] * g[1]) + (xv[r][2] * g[2] + xv[r][3] * g[3]); } }
        float mine[4] = {0.f, 0.f, 0.f, 0.f};
#pragma unroll
        for (int r = 0; r < 4; ++r) { ssq[r] = wave_sum(ssq[r]);
#pragma unroll
            for (int j = 0; j < 16; ++j) { const float v = wave_sum(acc[r][j]); if (lane == j) mine[r] = v; } }
#pragma unroll
        for (int r = 0; r < 4; ++r) { const int m = m0 + r, b = m >> 11, s = m & 2047;
            if (lane < 32) SS0[(size_t)m * 32 + lane] = lane == 0 ? ssq[r] : 0.f;
            if (lane < 16) { const float rs = pg8::rstd_of(ssq[r]); const int j = lane & 7; const float bias = lane < 8 ? b_ig[j] : b_fg[j];
                const float z = 15.0f * tanhf((mine[r] * rs + bias) * (1.0f / 15.0f));
                if (lane < 8) IG[(size_t)(b * 8 + j) * SEQ + s] = z; else FG[(size_t)(b * 8 + j) * SEQ + s] = -log1pf(expf(-z)); }
            else if (lane < 32) { const int i = lane - 16; const float ang = (float)pos[m] * a.invf[i];
                const double rev = (double)ang * 0.15915494309189533577; const float fr = (float)(rev - floor(rev));
                COS[(size_t)m * 16 + i] = __builtin_amdgcn_cosf(fr); SIN[(size_t)m * 16 + i] = __builtin_amdgcn_sinf(fr); } }
    }
}

__device__ __forceinline__ void p2_mlstm_recurrent(const Args& a, LAS unsigned char* lds) {
    const int tid = ltid();
    unsigned char* ws = a.ws;
    const bf16u* PROJ = (const bf16u*)(ws + WS_PROJ); const float* IG = (const float*)(ws + WS_IG); const float* FG = (const float*)(ws + WS_FG); float* HRAW = (float*)(ws + WS_HRAW);
    LAS float* qs = (LAS float*)lds; LAS float* ks = qs + 64 * 128; LAS float* vsl = ks + 64 * 128; LAS float* gi = vsl + 64 * 32; LAS float* gf = gi + 64;
    const int v = tid >> 4, dp = tid & 15;
    for (int unit = blockIdx.x; unit < 256; unit += gridDim.x) {
        const int bh = unit >> 3, vs = unit & 7, b = bh >> 3, h = bh & 7;
        float C[8], n[8]; float mst = 0.f;
#pragma unroll
        for (int e = 0; e < 8; ++e) { C[e] = 0.f; n[e] = 0.f; }
        for (int c = 0; c < 32; ++c) {
            __syncthreads();
            const size_t rowbase = (size_t)(b * SEQ + c * 64);
#pragma unroll
            for (int i = 0; i < 2; ++i) { const int idx = tid + 512 * i, row = idx >> 4, c8 = idx & 15;
                const u32x4 wq = *(const u32x4*)(PROJ + (rowbase + row) * 6144 + h * 128 + c8 * 8);
                const u32x4 wk = *(const u32x4*)(PROJ + (rowbase + row) * 6144 + 1024 + h * 128 + c8 * 8);
                LAS float* qd = qs + row * 128 + c8 * 8; LAS float* kd = ks + row * 128 + c8 * 8;
                qd[0] = bflo(wq.x); qd[1] = bfhi(wq.x); qd[2] = bflo(wq.y); qd[3] = bfhi(wq.y); qd[4] = bflo(wq.z); qd[5] = bfhi(wq.z); qd[6] = bflo(wq.w); qd[7] = bfhi(wq.w);
                kd[0] = bflo(wk.x); kd[1] = bfhi(wk.x); kd[2] = bflo(wk.y); kd[3] = bfhi(wk.y); kd[4] = bflo(wk.z); kd[5] = bfhi(wk.z); kd[6] = bflo(wk.w); kd[7] = bfhi(wk.w); }
            if (tid < 256) { const int row = tid >> 2, c8 = tid & 3;
                const u32x4 wv = *(const u32x4*)(PROJ + (rowbase + row) * 6144 + 2048 + h * 256 + vs * 32 + c8 * 8);
                LAS float* vd = vsl + row * 32 + c8 * 8;
                vd[0] = bflo(wv.x); vd[1] = bfhi(wv.x); vd[2] = bflo(wv.y); vd[3] = bfhi(wv.y); vd[4] = bflo(wv.z); vd[5] = bfhi(wv.z); vd[6] = bflo(wv.w); vd[7] = bfhi(wv.w); }
            else if (tid < 320) gi[tid - 256] = IG[(size_t)bh * SEQ + c * 64 + (tid - 256)];
            else if (tid < 384) gf[tid - 320] = FG[(size_t)bh * SEQ + c * 64 + (tid - 320)];
            __syncthreads();
            for (int t = 0; t < 64; ++t) {
                const float fg = gf[t], ig = gi[t];
                const float mn = fmaxf(fg + mst, ig); const float F = __expf(fg + mst - mn), I = __expf(ig - mn); mst = mn;
                const float vv = vsl[t * 32 + v] * I;
                const f32x4 q0 = *(const LAS f32x4*)(qs + t * 128 + dp * 8), q1 = *(const LAS f32x4*)(qs + t * 128 + dp * 8 + 4);
                const f32x4 k0 = *(const LAS f32x4*)(ks + t * 128 + dp * 8), k1 = *(const LAS f32x4*)(ks + t * 128 + dp * 8 + 4);
                float pn = 0.f, pd = 0.f;
#pragma unroll
                for (int e = 0; e < 4; ++e) { C[e] = F * C[e] + vv * k0[e]; n[e] = F * n[e] + I * k0[e]; pn += C[e] * q0[e]; pd += n[e] * q0[e];
                    C[4 + e] = F * C[4 + e] + vv * k1[e]; n[4 + e] = F * n[4 + e] + I * k1[e]; pn += C[4 + e] * q1[e]; pd += n[4 + e] * q1[e]; }
#pragma unroll
                for (int o = 1; o < 16; o <<= 1) { pn += __shfl_xor(pn, o); pd += __shfl_xor(pd, o); }
                if (dp == 0) HRAW[(rowbase + t) * DM + h * 256 + vs * 32 + v] = pn / fmaxf(fabsf(pd), __expf(-mst));
            }
        }
    }
}

typedef short bf16x8v __attribute__((ext_vector_type(8)));
__device__ __forceinline__ unsigned short f2bf1(float f) { return (unsigned short)(pk2(f, 0.f) & 0xffffu); }
constexpr int ML_DVS = 64, ML_NVT = ML_DVS / 16 + 1, ML_NVR = 16 * ML_NVT, ML_SPH = 256 / ML_DVS, ML_UNITS = 32 * ML_SPH;
__device__ __forceinline__ void p2_mlstm_chunk(const Args& a, LAS unsigned char* lds, int vblock, int vgrid) {
    const int tid = ltid(), lane = tid & 63, wave = __builtin_amdgcn_readfirstlane(tid >> 6), fr = lane & 15, fq = lane >> 4;
    unsigned char* ws = a.ws;
    const bf16u* PROJ = (const bf16u*)(ws + WS_PROJ); const float* IG = (const float*)(ws + WS_IG); const float* FG = (const float*)(ws + WS_FG); bf16u* HRAWB = (bf16u*)(ws + WS_HRAW);
    constexpr int QP = 136, TP = 72;
    LAS bf16u* Qs = (LAS bf16u*)lds;
    LAS bf16u* Ks = Qs + 64 * QP;
    LAS bf16u* KT = Ks + 64 * QP;
    LAS bf16u* VT = KT + 128 * TP;
    LAS bf16u* Ps = VT + ML_NVR * TP;
    LAS bf16u* Cb = Ps + 64 * TP;
    LAS float* AVs = (LAS float*)(Cb + 2 * ML_NVR * QP);
    LAS float* CMs = AVs + 32 * 64;
    LAS float* BSs = CMs + 32 * 64;
    LAS float* MCs = BSs + 32 * 64;
    for (int unit = vblock; unit < ML_UNITS; unit += vgrid) {
        const int bh = unit / ML_SPH, vs = unit % ML_SPH, b = bh >> 3, h = bh & 7;
        __syncthreads();
        for (int i = tid; i < 16 * 64; i += 512) { const int row = ML_DVS + (i >> 6), s = i & 63; VT[row * TP + s] = (row == ML_DVS) ? (bf16u)0x3F80u : (bf16u)0u; }
        for (int i = tid; i < ML_NVR * QP; i += 512) Cb[i] = (bf16u)0u;
#pragma unroll
        for (int k = 0; k < 4; ++k) { const int c = wave + 8 * k;
            float bsum = FG[(size_t)bh * SEQ + c * 64 + lane]; const float ig = IG[(size_t)bh * SEQ + c * 64 + lane];
#pragma unroll
            for (int d = 1; d < 64; d <<= 1) { const float t = __shfl_up(bsum, d); if (lane >= d) bsum += t; }
            const float av = ig - bsum; float cm = av;
#pragma unroll
            for (int d = 1; d < 64; d <<= 1) { const float t = __shfl_up(cm, d); if (lane >= d) cm = fmaxf(cm, t); }
            AVs[c * 64 + lane] = av; CMs[c * 64 + lane] = cm; BSs[c * 64 + lane] = bsum; }
        f32x4 cacc[ML_NVT][2];
#pragma unroll
        for (int v = 0; v < ML_NVT; ++v) { cacc[v][0] = (f32x4){0.f, 0.f, 0.f, 0.f}; cacc[v][1] = (f32x4){0.f, 0.f, 0.f, 0.f}; }
        u32x4 pq[2], pk[2], pv;
        pv = (u32x4){0u, 0u, 0u, 0u};
#define ML_LOAD(c_) do { const size_t rb_ = (size_t)(b * SEQ + (c_) * 64); \
            _Pragma("unroll") for (int i_ = 0; i_ < 2; ++i_) { const int idx_ = tid + 512 * i_, row_ = idx_ >> 4, c8_ = idx_ & 15, rowk_ = idx_ & 63, c8k_ = idx_ >> 6; \
                pq[i_] = *(const u32x4*)(PROJ + (rb_ + row_) * 6144 + h * 128 + c8_ * 8); pk[i_] = *(const u32x4*)(PROJ + (rb_ + rowk_) * 6144 + 1024 + h * 128 + c8k_ * 8); } \
            if (tid < 8 * ML_DVS) pv = *(const u32x4*)(PROJ + (rb_ + (tid & 63)) * 6144 + 2048 + h * 256 + vs * ML_DVS + (tid >> 6) * 8); } while (0)
        ML_LOAD(0);
        __syncthreads();
        if (wave == 0) {
            const float Bc = BSs[(lane & 31) * 64 + 63], Ac = CMs[(lane & 31) * 64 + 63]; float m = 0.f, mine = 0.f;
#pragma unroll
            for (int c = 0; c < 32; ++c) { if (lane == c) mine = m;
                m = __uint_as_float(__builtin_amdgcn_readlane(__float_as_uint(Bc), c)) + fmaxf(m, __uint_as_float(__builtin_amdgcn_readlane(__float_as_uint(Ac), c))); }
            if (lane < 32) MCs[lane] = mine; }
        for (int c = 0; c < 32; ++c) {
            const size_t rowbase = (size_t)(b * SEQ + c * 64);
#pragma unroll
            for (int i = 0; i < 2; ++i) { const int idx = tid + 512 * i, row = idx >> 4, c8 = idx & 15, rowk = idx & 63, c8k = idx >> 6;
                *(LAS u32x4*)(Qs + row * QP + c8 * 8) = pq[i]; *(LAS u32x4*)(Ks + rowk * QP + c8k * 8) = pk[i];
#pragma unroll
                for (int q = 0; q < 4; ++q) { KT[(c8k * 8 + 2 * q) * TP + rowk] = (bf16u)(pk[i][q] & 0xffffu); KT[(c8k * 8 + 2 * q + 1) * TP + rowk] = (bf16u)(pk[i][q] >> 16); } }
            if (tid < 8 * ML_DVS) { const int row = tid & 63, c8 = tid >> 6;
#pragma unroll
                for (int q = 0; q < 4; ++q) { VT[(c8 * 8 + 2 * q) * TP + row] = (bf16u)(pv[q] & 0xffffu); VT[(c8 * 8 + 2 * q + 1) * TP + row] = (bf16u)(pv[q] >> 16); } }
            if (c + 1 < 32) ML_LOAD(c + 1);
            __syncthreads();
            const float mc = MCs[c], M63 = fmaxf(mc, CMs[c * 64 + 63]);
            { const int i = wave >> 1; const f32x4 cm4 = *(const LAS f32x4*)(CMs + c * 64 + 16 * i + 4 * fq);
#pragma unroll
              for (int j2 = 0; j2 < 2; ++j2) { const int j = (wave & 1) * 2 + j2;
                if (j <= i) { f32x4 acc = (f32x4){0.f, 0.f, 0.f, 0.f};
#pragma unroll
                    for (int ks = 0; ks < 4; ++ks) { const bf16x8v A = *(const LAS bf16x8v*)(Qs + (16 * i + fr) * QP + 32 * ks + 8 * fq), B = *(const LAS bf16x8v*)(Ks + (16 * j + fr) * QP + 32 * ks + 8 * fq);
                        acc = __builtin_amdgcn_mfma_f32_16x16x32_bf16(A, B, acc, 0, 0, 0); }
                    const int s = 16 * j + fr; const float a_s = AVs[c * 64 + s];
#pragma unroll
                    for (int e = 0; e < 4; ++e) { const int t = 16 * i + 4 * fq + e; const float M_t = fmaxf(mc, cm4[e]);
                        const float p = (s <= t) ? acc[e] * __expf(a_s - M_t) : 0.f; Ps[t * TP + s] = f2bf1(p); } }
                else {
#pragma unroll
                    for (int e = 0; e < 4; ++e) Ps[(16 * i + 4 * fq + e) * TP + 16 * j + fr] = (bf16u)0u; } } }
            __syncthreads();
            if (wave < 4) {
                const int i = wave; const LAS bf16u* cb = Cb + (c & 1) * ML_NVR * QP;
                f32x4 a1[ML_NVT], a2[ML_NVT];
#pragma unroll
                for (int v = 0; v < ML_NVT; ++v) { a1[v] = (f32x4){0.f, 0.f, 0.f, 0.f}; a2[v] = (f32x4){0.f, 0.f, 0.f, 0.f}; }
#pragma unroll
                for (int ks = 0; ks < 4; ++ks) { const bf16x8v A = *(const LAS bf16x8v*)(Qs + (16 * i + fr) * QP + 32 * ks + 8 * fq);
#pragma unroll
                    for (int v = 0; v < ML_NVT; ++v) { const bf16x8v B = *(const LAS bf16x8v*)(cb + (16 * v + fr) * QP + 32 * ks + 8 * fq); a1[v] = __builtin_amdgcn_mfma_f32_16x16x32_bf16(A, B, a1[v], 0, 0, 0); } }
#pragma unroll
                for (int ks = 0; ks < 2; ++ks) { const bf16x8v A = *(const LAS bf16x8v*)(Ps + (16 * i + fr) * TP + 32 * ks + 8 * fq);
#pragma unroll
                    for (int v = 0; v < ML_NVT; ++v) { const bf16x8v B = *(const LAS bf16x8v*)(VT + (16 * v + fr) * TP + 32 * ks + 8 * fq); a2[v] = __builtin_amdgcn_mfma_f32_16x16x32_bf16(A, B, a2[v], 0, 0, 0); } }
                const f32x4 cm4 = *(const LAS f32x4*)(CMs + c * 64 + 16 * i + 4 * fq), bs4 = *(const LAS f32x4*)(BSs + c * 64 + 16 * i + 4 * fq);
#pragma unroll
                for (int e = 0; e < 4; ++e) { const int t = 16 * i + 4 * fq + e; const float M_t = fmaxf(mc, cm4[e]); const float wi = __expf(mc - M_t), ei = __expf(-bs4[e] - M_t);
                    float den = wi * a1[ML_NVT - 1][e] + a2[ML_NVT - 1][e]; den = __shfl(den, lane & 48);
                    const float rdn = __builtin_amdgcn_rcpf(fmaxf(fabsf(den), ei)); bf16u* hrow = HRAWB + (rowbase + t) * DM + h * 256 + vs * ML_DVS + fr;
#pragma unroll
                    for (int v = 0; v < ML_NVT - 1; ++v) hrow[16 * v] = f2bf1((wi * a1[v][e] + a2[v][e]) * rdn); }
            } else {
                const int w4 = wave - 4; LAS bf16u* nb = Cb + ((c + 1) & 1) * ML_NVR * QP; const float decay = __expf(mc - M63);
#pragma unroll
                for (int v = 0; v < ML_NVT; ++v) { cacc[v][0] = cacc[v][0] * decay; cacc[v][1] = cacc[v][1] * decay; }
#pragma unroll
                for (int ks = 0; ks < 2; ++ks) { const f32x4 av0 = *(const LAS f32x4*)(AVs + c * 64 + 32 * ks + 8 * fq), av1 = *(const LAS f32x4*)(AVs + c * 64 + 32 * ks + 8 * fq + 4); float wgf[8];
#pragma unroll
                    for (int e = 0; e < 4; ++e) { wgf[e] = __expf(av0[e] - M63); wgf[4 + e] = __expf(av1[e] - M63); }
                    const bf16x8v B0 = *(const LAS bf16x8v*)(KT + (16 * (2 * w4) + fr) * TP + 32 * ks + 8 * fq), B1 = *(const LAS bf16x8v*)(KT + (16 * (2 * w4 + 1) + fr) * TP + 32 * ks + 8 * fq);
#pragma unroll
                    for (int v = 0; v < ML_NVT; ++v) { const u32x4 raw = *(const LAS u32x4*)(VT + (16 * v + fr) * TP + 32 * ks + 8 * fq); u32x4 sc;
#pragma unroll
                        for (int q = 0; q < 4; ++q) sc[q] = pk2(bflo(raw[q]) * wgf[2 * q], bfhi(raw[q]) * wgf[2 * q + 1]);
                        const bf16x8v A = __builtin_bit_cast(bf16x8v, sc);
                        cacc[v][0] = __builtin_amdgcn_mfma_f32_16x16x32_bf16(A, B0, cacc[v][0], 0, 0, 0); cacc[v][1] = __builtin_amdgcn_mfma_f32_16x16x32_bf16(A, B1, cacc[v][1], 0, 0, 0); } }
#pragma unroll
                for (int v = 0; v < ML_NVT; ++v)
#pragma unroll
                    for (int dd = 0; dd < 2; ++dd)
#pragma unroll
                        for (int e = 0; e < 4; ++e) nb[(16 * v + 4 * fq + e) * QP + 16 * (2 * w4 + dd) + fr] = f2bf1(cacc[v][dd][e]);
            }
            __syncthreads();
        }
#undef ML_LOAD
    }
}

__device__ __forceinline__ void p3_hnorm(const Args& a) {
    const int tid = ltid(), lane = tid & 63, wave = __builtin_amdgcn_readfirstlane(tid >> 6);
    unsigned char* ws = a.ws;
    const bf16u* HRAW = (const bf16u*)(ws + WS_HRAW); const bf16u* PROJ = (const bf16u*)(ws + WS_PROJ); bf16u* HN = (bf16u*)(ws + WS_HN); const float* w_hn = (const float*)a.in[6];
    const int gw = blockIdx.x * NWAVES + wave, NGW = gridDim.x * NWAVES;
    for (int it = gw; it < MTOK * 8; it += NGW) { const int m = it >> 3, h = it & 7; const size_t off = (size_t)m * DM + h * 256 + 4 * lane;
        const u32x2 hw = __builtin_nontemporal_load((const u32x2*)(HRAW + off)); const f32x4 hv = {bflo(hw.x), bfhi(hw.x), bflo(hw.y), bfhi(hw.y)};
        const float ss = wave_sum((hv[0] * hv[0] + hv[1] * hv[1]) + (hv[2] * hv[2] + hv[3] * hv[3]));
        const float rs = rsqrtf(ss * (1.0f / 256.0f) + 1e-6f);
        const u32x2 og = __builtin_nontemporal_load((const u32x2*)(PROJ + (size_t)m * 6144 + 4096 + h * 256 + 4 * lane));
        const f32x4 w = *(const f32x4*)(w_hn + h * 256 + 4 * lane);
        const float o0 = bflo(og.x), o1 = bfhi(og.x), o2 = bflo(og.y), o3 = bfhi(og.y);
        const float r0 = hv[0] * rs * w[0] / (1.f + __expf(-o0)), r1 = hv[1] * rs * w[1] / (1.f + __expf(-o1));
        const float r2 = hv[2] * rs * w[2] / (1.f + __expf(-o2)), r3 = hv[3] * rs * w[3] / (1.f + __expf(-o3));
        u32x2 o; o.x = pk2(r0, r1); o.y = pk2(r2, r3); *(u32x2*)(HN + off) = o; }
}

__device__ __forceinline__ void p_conv(const Args& a, int layer) {
    const int tid = ltid();
    unsigned char* ws = a.ws;
    const bf16u* U = (const bf16u*)(ws + WS_U); bf16u* ACT = (bf16u*)(ws + WS_ACT);
    const float* cw = (const float*)a.in[20] + (size_t)layer * 3 * 11264; const float* cb = (const float*)a.in[21] + (size_t)layer * 11264;
    constexpr int NCG = DFF / 8, RUN = 16, NITEM = NCG * (MTOK / RUN);
    for (int idx = blockIdx.x * 512 + tid; idx < NITEM; idx += gridDim.x * 512) {
        const int cgp = idx % NCG, rr = idx / NCG, f0 = cgp * 8, m0 = rr * RUN;
        float wg[3][8], wv[3][8], bg[8], bv[8], p2g[8], p1g[8], p2v[8], p1v[8];
#pragma unroll
        for (int j = 0; j < 3; ++j) {
#pragma unroll
            for (int q = 0; q < 2; ++q) { const f32x4 g4 = *(const f32x4*)(cw + j * 11264 + f0 + 4 * q), v4 = *(const f32x4*)(cw + j * 11264 + DFF + f0 + 4 * q);
#pragma unroll
                for (int e = 0; e < 4; ++e) { wg[j][4 * q + e] = g4[e]; wv[j][4 * q + e] = v4[e]; } } }
#pragma unroll
        for (int q = 0; q < 2; ++q) { const f32x4 g4 = *(const f32x4*)(cb + f0 + 4 * q), v4 = *(const f32x4*)(cb + DFF + f0 + 4 * q);
#pragma unroll
            for (int e = 0; e < 4; ++e) { bg[4 * q + e] = g4[e]; bv[4 * q + e] = v4[e]; } }
#pragma unroll
        for (int e = 0; e < 8; ++e) { p2g[e] = 0.f; p1g[e] = 0.f; p2v[e] = 0.f; p1v[e] = 0.f; }
        if ((m0 & (SEQ - 1)) != 0) {
            const u32x4 a2 = *(const u32x4*)(U + (size_t)(m0 - 2) * 11264 + f0), a1 = *(const u32x4*)(U + (size_t)(m0 - 1) * 11264 + f0);
            const u32x4 b2 = *(const u32x4*)(U + (size_t)(m0 - 2) * 11264 + DFF + f0), b1 = *(const u32x4*)(U + (size_t)(m0 - 1) * 11264 + DFF + f0);
#pragma unroll
            for (int q = 0; q < 4; ++q) { p2g[2 * q] = bflo(a2[q]); p2g[2 * q + 1] = bfhi(a2[q]); p1g[2 * q] = bflo(a1[q]); p1g[2 * q + 1] = bfhi(a1[q]);
                p2v[2 * q] = bflo(b2[q]); p2v[2 * q + 1] = bfhi(b2[q]); p1v[2 * q] = bflo(b1[q]); p1v[2 * q + 1] = bfhi(b1[q]); }
        }
#pragma unroll 4
        for (int r = 0; r < RUN; ++r) {
            const u32x4 ug = *(const u32x4*)(U + (size_t)(m0 + r) * 11264 + f0), uv = *(const u32x4*)(U + (size_t)(m0 + r) * 11264 + DFF + f0);
            float cg_[8], cv_[8], o[8];
#pragma unroll
            for (int q = 0; q < 4; ++q) { cg_[2 * q] = bflo(ug[q]); cg_[2 * q + 1] = bfhi(ug[q]); cv_[2 * q] = bflo(uv[q]); cv_[2 * q + 1] = bfhi(uv[q]); }
#pragma unroll
            for (int e = 0; e < 8; ++e) { const float g = bg[e] + wg[0][e] * p2g[e] + wg[1][e] * p1g[e] + wg[2][e] * cg_[e];
                const float vv = bv[e] + wv[0][e] * p2v[e] + wv[1][e] * p1v[e] + wv[2][e] * cv_[e];
                o[e] = g / (1.f + __expf(-g)) * vv; p2g[e] = p1g[e]; p1g[e] = cg_[e]; p2v[e] = p1v[e]; p1v[e] = cv_[e]; }
            u32x4 w; w.x = pk2(o[0], o[1]); w.y = pk2(o[2], o[3]); w.z = pk2(o[4], o[5]); w.w = pk2(o[6], o[7]);
            *(u32x4*)(ACT + (size_t)(m0 + r) * DFF + f0) = w;
        }
    }
}


__device__ __forceinline__ void p_convfix(const Args& a, int layer) {
    const int tid = ltid();
    unsigned char* ws = a.ws;
    const bf16u* US = (const bf16u*)(ws + WS_U); bf16u* ACT = (bf16u*)(ws + WS_ACT);
    const float* cw = (const float*)a.in[20] + (size_t)layer * 3 * 11264; const float* cb = (const float*)a.in[21] + (size_t)layer * 11264;
    constexpr int NCG = DFF / 8, NITEM = NCG * (MTOK / 64);
    for (int idx = blockIdx.x * 512 + tid; idx < NITEM; idx += gridDim.x * 512) {
        const int cgp = idx % NCG, k = idx / NCG, f0 = cgp * 8;
        float x[4][2][8];
#pragma unroll
        for (int q = 0; q < 4; ++q) { const bool zero = (q < 2) && ((k & 31) == 0); const int kk = q < 2 ? k - 1 : k;
#pragma unroll
            for (int gv = 0; gv < 2; ++gv) { u32x4 w = (u32x4){0u, 0u, 0u, 0u};
                if (!zero) w = *(const u32x4*)(US + (size_t)(kk * 4 + q) * 11264 + gv * DFF + f0);
#pragma unroll
                for (int e = 0; e < 4; ++e) { x[q][gv][2 * e] = bflo(w[e]); x[q][gv][2 * e + 1] = bfhi(w[e]); } } }
        float o0[8], o1[8];
#pragma unroll
        for (int h = 0; h < 2; ++h) { const f32x4 wg0 = *(const f32x4*)(cw + f0 + 4 * h), wg1 = *(const f32x4*)(cw + 11264 + f0 + 4 * h), wg2 = *(const f32x4*)(cw + 22528 + f0 + 4 * h), bg = *(const f32x4*)(cb + f0 + 4 * h);
            const f32x4 wv0 = *(const f32x4*)(cw + DFF + f0 + 4 * h), wv1 = *(const f32x4*)(cw + 11264 + DFF + f0 + 4 * h), wv2 = *(const f32x4*)(cw + 22528 + DFF + f0 + 4 * h), bv = *(const f32x4*)(cb + DFF + f0 + 4 * h);
#pragma unroll
            for (int j = 0; j < 4; ++j) { const int e = 4 * h + j;
                const float ga = bg[j] + wg0[j] * x[0][0][e] + wg1[j] * x[1][0][e] + wg2[j] * x[2][0][e], va = bv[j] + wv0[j] * x[0][1][e] + wv1[j] * x[1][1][e] + wv2[j] * x[2][1][e];
                const float gb = bg[j] + wg0[j] * x[1][0][e] + wg1[j] * x[2][0][e] + wg2[j] * x[3][0][e], vb = bv[j] + wv0[j] * x[1][1][e] + wv1[j] * x[2][1][e] + wv2[j] * x[3][1][e];
                o0[e] = ga / (1.f + __expf(-ga)) * va; o1[e] = gb / (1.f + __expf(-gb)) * vb; } }
        u32x4 w; w.x = pk2(o0[0], o0[1]); w.y = pk2(o0[2], o0[3]); w.z = pk2(o0[4], o0[5]); w.w = pk2(o0[6], o0[7]);
        *(u32x4*)(ACT + (size_t)(64 * k) * DFF + f0) = w;
        w.x = pk2(o1[0], o1[1]); w.y = pk2(o1[2], o1[3]); w.z = pk2(o1[4], o1[5]); w.w = pk2(o1[6], o1[7]);
        *(u32x4*)(ACT + (size_t)(64 * k + 1) * DFF + f0) = w;
    }
}

__device__ __forceinline__ attn::BlockRef<attn::bf16, attn::bf16> att_ref(unsigned char* ws, int L, int pass) {
    const int xcd = L & 7, k = L >> 3, bh = xcd * 4 + (k >> 4), within = k & 15, virt = within >> 2, x = within & 3, c = virt >> 1, half = virt & 1, b = bh >> 3, h = bh & 7;
    const int qb = pass ? 7 - x : x;
    attn::bf16* QH = (attn::bf16*)(ws + WS_QH); attn::bf16* KH = QH + (size_t)MTOK * DM; attn::bf16* VH = KH + (size_t)MTOK * DM; attn::bf16* OH = (attn::bf16*)(ws + WS_OH);
    attn::BlockRef<attn::bf16, attn::bf16> r;
    r.Q = QH + ((size_t)(b * 16 + 2 * h + c) * SEQ + (size_t)qb * 256) * 128;
    r.K = KH + (size_t)(b * 16 + 2 * h + c) * SEQ * 128;
    r.V = VH + (size_t)(b * 16 + 2 * h + half) * SEQ * 128;
    r.O = OH + ((size_t)(b * 32 + (2 * h + c) * 2 + half) * SEQ + (size_t)qb * 256) * 128;
    r.P0 = qb * 256;
    return r;
}
__device__ __forceinline__ void p_attention(const Args& a, char* lds) {
    typedef attn::BlockRef<attn::bf16, attn::bf16> BR;
    const int total = 512, stride = gridDim.x; int L = blockIdx.x; if (L >= total) return;
    int pass = 0; BR cur = att_ref(a.ws, L, 0);
    attn::Seam<attn::bf16> S;
    attn::causal_swa_prime<attn::bf16, attn::bf16>(cur, SEQ, lds, S);
    for (;;) {
        const bool more_pass = pass == 0, more_item = L + stride < total, last = !more_pass && !more_item;
        int passn = pass + 1, Ln = L;
        if (!more_pass) { passn = 0; Ln = more_item ? L + stride : L; }
        const BR nxt = last ? cur : att_ref(a.ws, Ln, passn);
        attn::causal_swa_block<attn::bf16, attn::bf16>(cur, nxt, SEQ, SEQ, lds, S);
        if (last) break;
        cur = nxt; pass = passn; L = Ln;
    }
}

__device__ __forceinline__ void p_diffnorm(const Args& a) {
    const int tid = ltid(), lane = tid & 63, wave = __builtin_amdgcn_readfirstlane(tid >> 6);
    unsigned char* ws = a.ws;
    const bf16u* OH = (const bf16u*)(ws + WS_OH); bf16u* ON = (bf16u*)(ws + WS_ON); const float* subln = (const float*)a.in[16];
    const float* lq1 = (const float*)a.in[12]; const float* lk1 = (const float*)a.in[13]; const float* lq2 = (const float*)a.in[14]; const float* lk2 = (const float*)a.in[15];
    const float d1 = wave_sum(lq1[lane] * lk1[lane] + lq1[lane + 64] * lk1[lane + 64]), d2 = wave_sum(lq2[lane] * lk2[lane] + lq2[lane + 64] * lk2[lane + 64]);
    const float lam = expf(d1) - expf(d2) + LAMBDA_INIT;
    const int gw = blockIdx.x * NWAVES + wave, NGW = gridDim.x * NWAVES;
    const int vh = lane >> 5, d = (lane & 31) * 4;
    const f32x4 g = *(const f32x4*)(subln + vh * 128 + d);
    for (int it = gw; it < MTOK * 8; it += NGW) { const int m = it >> 3, h = it & 7, b = m >> 11, s = m & 2047;
        const u32x2 w0 = __builtin_nontemporal_load((const u32x2*)(OH + ((size_t)(b * 32 + (2 * h + 0) * 2 + vh) * SEQ + s) * 128 + d));
        const u32x2 w1 = __builtin_nontemporal_load((const u32x2*)(OH + ((size_t)(b * 32 + (2 * h + 1) * 2 + vh) * SEQ + s) * 128 + d));
        const float e0 = bflo(w0.x) - lam * bflo(w1.x), e1 = bfhi(w0.x) - lam * bfhi(w1.x), e2 = bflo(w0.y) - lam * bflo(w1.y), e3 = bfhi(w0.y) - lam * bfhi(w1.y);
        const float ss = wave_sum((e0 * e0 + e1 * e1) + (e2 * e2 + e3 * e3));
        const float rs = rsqrtf(ss * (1.0f / 256.0f) + 1e-6f) * (1.0f - LAMBDA_INIT);
        u32x2 o; o.x = pk2(e0 * rs * g[0], e1 * rs * g[1]); o.y = pk2(e2 * rs * g[2], e3 * rs * g[3]);
        *(u32x2*)(ON + (size_t)m * DM + h * 256 + vh * 128 + d) = o; }
}

__device__ __forceinline__ void p_final(const Args& a) {
    const int tid = ltid(), lane = tid & 63, wave = __builtin_amdgcn_readfirstlane(tid >> 6);
    const bf16u* XBf = (const bf16u*)(a.ws + WS_XB); const float* fn = (const float*)a.in[23];
    const int gw = blockIdx.x * NWAVES + wave, NGW = gridDim.x * NWAVES;
    f32x4 g[8];
#pragma unroll
    for (int j = 0; j < 4; ++j) { const int c = 8 * (lane + 64 * j); g[2 * j] = *(const f32x4*)(fn + c); g[2 * j + 1] = *(const f32x4*)(fn + c + 4); }
    for (int m0 = gw; m0 < MTOK; m0 += 4 * NGW) {
        u32x4 w[4][4];
#pragma unroll
        for (int r = 0; r < 4; ++r) { const int m = m0 + r * NGW; const u32x4* xr = (const u32x4*)(XBf + (size_t)(m < MTOK ? m : m0) * DM) + lane;
#pragma unroll
            for (int j = 0; j < 4; ++j) w[r][j] = __builtin_nontemporal_load(xr + 64 * j); }
#pragma unroll
        for (int r = 0; r < 4; ++r) { const int m = m0 + r * NGW; if (m >= MTOK) break;
            f32x4 v[8]; float s = 0.f;
#pragma unroll
            for (int j = 0; j < 4; ++j) { const u32x4 q = w[r][j];
                v[2 * j] = (f32x4){bflo(q.x), bfhi(q.x), bflo(q.y), bfhi(q.y)}; v[2 * j + 1] = (f32x4){bflo(q.z), bfhi(q.z), bflo(q.w), bfhi(q.w)};
                s += (v[2 * j][0] * v[2 * j][0] + v[2 * j][1] * v[2 * j][1]) + (v[2 * j][2] * v[2 * j][2] + v[2 * j][3] * v[2 * j][3]);
                s += (v[2 * j + 1][0] * v[2 * j + 1][0] + v[2 * j + 1][1] * v[2 * j + 1][1]) + (v[2 * j + 1][2] * v[2 * j + 1][2] + v[2 * j + 1][3] * v[2 * j + 1][3]); }
            const float rs = pg8::rstd_of(wave_sum(s)); float* orow = a.out + (size_t)m * DM;
#pragma unroll
            for (int j = 0; j < 4; ++j) { const int c = 8 * (lane + 64 * j);
                __builtin_nontemporal_store(v[2 * j] * rs * g[2 * j], (f32x4*)(orow + c)); __builtin_nontemporal_store(v[2 * j + 1] * rs * g[2 * j + 1], (f32x4*)(orow + c + 4)); } }
    }
}

template <class Epi> __device__ __forceinline__ void run_gemm(LAS unsigned char* lds, const bf16u* A, const bf16u* Bt, int N, int K, const Epi& E) {
    pg8::Gemm g{A, Bt, MTOK, N, K}; pg8::StaticOrder S; S.init(MTOK, N, (int)gridDim.x, (int)blockIdx.x);
    pg8::gemm_phase<Epi, pg8::StaticOrder, true, true>((PG8_LAS unsigned char*)lds, g, S, E);
}

#define XB_TMO      128
#define XB_XCNT(j)  (256  + 64 * (j))
#define XB_XSUB(j)  (1280 + 64 * (j))
#define XB_XGEN(j)  (2304 + 64 * (j))
#define XB_TOP      3328
#define XB_TOPGEN   3392
#define XCD_BAR_WORDS 3456
#define XB_SPIN_CAP (1u << 18)

__device__ __forceinline__ unsigned xb_ld(unsigned* p)              { return __hip_atomic_load(p, __ATOMIC_RELAXED, __HIP_MEMORY_SCOPE_AGENT); }
__device__ __forceinline__ unsigned xb_add(unsigned* p, unsigned v) { return __hip_atomic_fetch_add(p, v, __ATOMIC_RELAXED, __HIP_MEMORY_SCOPE_AGENT); }
__device__ __forceinline__ unsigned xb_xcc_id() { return (unsigned)__builtin_amdgcn_s_getreg((3 << 11) | 20) & 0xFu; }
#define XB_SPIN(cond, bar) do { unsigned _sp = 0; while (cond) { __builtin_amdgcn_s_sleep(1); \
    if ((++_sp & 255u) == 0u) { if (xb_ld(&(bar)[XB_TMO])) break; if (_sp > XB_SPIN_CAP) { atomicAdd(&(bar)[XB_TMO], 1u); break; } } } } while (0)

struct XcdBarrier {
    unsigned* bar; unsigned x;
    volatile LAS unsigned* st;
};

__device__ __forceinline__ XcdBarrier xcd_barrier_post(unsigned* bar, volatile LAS unsigned* st) {
    XcdBarrier b; b.bar = bar; b.x = xb_xcc_id(); b.st = st;
    if (threadIdx.x == 0) (void)xb_add(&bar[XB_XCNT(b.x)], 1u);
    return b;
}
__device__ __forceinline__ void xcd_barrier_complete(unsigned* bar, unsigned x, unsigned& nloc, unsigned& nx) {
    const unsigned G = gridDim.x * gridDim.y * gridDim.z;
    unsigned sum, cnt, mine, sp = 0u;
    for (;;) {
        sum = 0u; cnt = 0u; mine = 0u;
#pragma unroll
        for (unsigned j = 0; j < 16; ++j) { const unsigned c = xb_ld(&bar[XB_XCNT(j)]); sum += c; cnt += (c > 0u) ? 1u : 0u; mine = (j == x) ? c : mine; }
        if (sum == G) break;
        __builtin_amdgcn_s_sleep(1);
        if ((++sp & 255u) == 0u) { if (xb_ld(&bar[XB_TMO])) break; if (sp > XB_SPIN_CAP) { atomicAdd(&bar[XB_TMO], 1u); break; } }
    }
    nloc = mine > 0u ? mine : 1u; nx = cnt > 0u ? cnt : 1u;
}

__device__ __forceinline__ void xcd_barrier(const XcdBarrier& b) {
    asm volatile("s_waitcnt vmcnt(0)" ::: "memory");
    __syncthreads();
    if (threadIdx.x == 0) {
        unsigned* bar = b.bar;
        __builtin_amdgcn_s_waitcnt(0);
        unsigned nloc = b.st[0], nx = b.st[1];
        if (nloc == 0u) { xcd_barrier_complete(bar, b.x, nloc, nx); b.st[0] = nloc; b.st[1] = nx; }
        const unsigned old = xb_add(&bar[XB_XSUB(b.x)], 1u);
        const unsigned gen = old / nloc;
        if (old + 1u == (gen + 1u) * nloc) {
            __builtin_amdgcn_fence(__ATOMIC_RELEASE, "agent");
            asm volatile("s_waitcnt vmcnt(0)" ::: "memory");
            const unsigned og = xb_add(&bar[XB_TOP], 1u);
            const unsigned tg = og / nx;
            if (og + 1u == (tg + 1u) * nx) xb_add(&bar[XB_TOPGEN], 1u);
            else XB_SPIN(xb_ld(&bar[XB_TOPGEN]) == tg, bar);
            __builtin_amdgcn_fence(__ATOMIC_ACQUIRE, "agent");
            xb_add(&bar[XB_XGEN(b.x)], 1u);
            asm volatile("s_waitcnt vmcnt(0)" ::: "memory");
        } else {
            XB_SPIN(xb_ld(&bar[XB_XGEN(b.x)]) == gen, bar);
            __builtin_amdgcn_fence(__ATOMIC_ACQUIRE, "agent");
            asm volatile("s_waitcnt vmcnt(0)" ::: "memory");
        }
    }
    __syncthreads();
}

__global__ void __launch_bounds__(512, 2) fwd_megakernel(Args a) {
    extern __shared__ __attribute__((aligned(16))) unsigned char lds[];
    cg::grid_group grid = cg::this_grid();
    LAS unsigned char* L = (LAS unsigned char*)lds;
    unsigned char* ws = a.ws;
    float* SS = (float*)(ws + WS_SSP); constexpr int SSN = MTOK * 32; bf16u* XB = (bf16u*)(ws + WS_XB); float* R = (float*)(ws + WS_R);
    if (threadIdx.x < 2) ((volatile LAS unsigned*)(L + LDS_CTL))[threadIdx.x] = 0u;
    __syncthreads();
    XcdBarrier xbar = xcd_barrier_post((unsigned*)(ws + WS_BAR), (volatile LAS unsigned*)(L + LDS_CTL));
#define GSYNC() xcd_barrier(xbar)
#define GSYNC0() xcd_barrier(xbar)
    if (__builtin_expect(a.out == nullptr, 0)) { asm volatile("s_waitcnt vmcnt(0) lgkmcnt(0)" ::: "memory"); __syncthreads(); grid.sync(); __builtin_amdgcn_fence(__ATOMIC_ACQUIRE, "agent"); asm volatile("s_waitcnt vmcnt(0)" ::: "memory"); __syncthreads(); }
#ifndef NO_P0
    p0_prologue(a, L);
#ifdef DUP_P0
    __syncthreads(); p0_prologue(a, L);
#endif
#endif
    GSYNC0();
    { pg8::EpiScaleBf16 E{(bf16u*)(ws + WS_PROJ), 6144, SS, 4, QSCALE}; run_gemm(L, XB, (const bf16u*)(ws + WS_WIN), 6144, 2048, E); }
#ifdef DUP_INPROJ
    GSYNC();
    { pg8::EpiScaleBf16 E{(bf16u*)(ws + WS_PROJ), 6144, SS, 4, QSCALE}; run_gemm(L, XB, (const bf16u*)(ws + WS_WIN), 6144, 2048, E); }
#endif
    GSYNC();
#ifndef NO_ML
    if ((int)gridDim.x == 256) { if ((int)blockIdx.x < 128) p2_mlstm_chunk(a, L, ((int)blockIdx.x & 7) * 16 + ((int)blockIdx.x >> 3), 128);
        else { const int t_ = ltid(); convert_weights(a, CW_MID, CW_EARLY, ((int)blockIdx.x - 128) * NWAVES + (t_ >> 6), 128 * NWAVES, t_ & 63); convert_weights(a, CW_EARLY + CW_I7, CW_ALL, ((int)blockIdx.x - 128) * NWAVES + (t_ >> 6), 128 * NWAVES, t_ & 63); } }
    else { p2_mlstm_chunk(a, L, (int)blockIdx.x, (int)gridDim.x); const int t_ = ltid(); convert_weights(a, CW_MID, CW_EARLY, (int)blockIdx.x * NWAVES + (t_ >> 6), (int)gridDim.x * NWAVES, t_ & 63); }
#ifdef DUP_ML
    __syncthreads(); p2_mlstm_chunk(a, L, (int)blockIdx.x, (int)gridDim.x);
#endif
#endif
    GSYNC();
    p3_hnorm(a);
    GSYNC();
    { pg8::EpiResid E{nullptr, XB, SS + SSN};     run_gemm(L, (const bf16u*)(ws + WS_HN), (const bf16u*)(ws + WS_WOUT), 2048, 2048, E); }
    GSYNC();
    { pg8::EpiConvAct E{(bf16u*)(ws + WS_ACT), (bf16u*)(ws + WS_U), SS + SSN, (const float*)a.in[20], (const float*)a.in[21]}; run_gemm(L, XB, (const bf16u*)(ws + WS_WUP0), 11264, 2048, E); }
    if ((int)gridDim.x == 256 && (int)blockIdx.x >= 128) { const int t_ = ltid(); convert_weights(a, CW_EARLY, CW_EARLY + CW_I7, ((int)blockIdx.x - 128) * NWAVES + (t_ >> 6), 128 * NWAVES, t_ & 63); }
    else if ((int)gridDim.x != 256) { const int t_ = ltid(); convert_weights(a, CW_EARLY, CW_ALL, (int)blockIdx.x * NWAVES + (t_ >> 6), (int)gridDim.x * NWAVES, t_ & 63); }
    GSYNC();
#ifndef NO_FIX
    p_convfix(a, 0);
#endif
    GSYNC();
    { pg8::EpiResid E{nullptr, XB, SS + 2 * SSN}; run_gemm(L, (const bf16u*)(ws + WS_ACT), (const bf16u*)(ws + WS_WDN0), 2048, 5632, E); }
    GSYNC();
    { pg8::EpiQKV E{(bf16u*)(ws + WS_QH), SS + 2 * SSN, (const float*)(ws + WS_COS), (const float*)(ws + WS_SIN)}; run_gemm(L, XB, (const bf16u*)(ws + WS_WQKV), 6144, 2048, E); }
    GSYNC();
#ifndef NO_ATT
    p_attention(a, (char*)lds);
#ifdef DUP_ATT
    __syncthreads(); p_attention(a, (char*)lds);
#endif
#endif
    GSYNC();
    p_diffnorm(a);
    GSYNC();
    { pg8::EpiResid E{nullptr, XB, SS + 3 * SSN}; run_gemm(L, (const bf16u*)(ws + WS_ON), (const bf16u*)(ws + WS_WO), 2048, 2048, E); }
    GSYNC();
    { pg8::EpiConvAct E{(bf16u*)(ws + WS_ACT), (bf16u*)(ws + WS_U), SS + 3 * SSN, (const float*)a.in[20] + 3 * 11264, (const float*)a.in[21] + 11264}; run_gemm(L, XB, (const bf16u*)(ws + WS_WUP1), 11264, 2048, E); }
    GSYNC();
#ifndef NO_FIX
    p_convfix(a, 1);
#endif
    GSYNC();
    { pg8::EpiResid E{nullptr, XB, SS}; run_gemm(L, (const bf16u*)(ws + WS_ACT), (const bf16u*)(ws + WS_WDN1), 2048, 5632, E); }
    GSYNC();
    p_final(a);
}

extern "C" void kernel_launch(void* const* d_in, const int* in_sizes, int n_in, void* d_out, int out_size, void* d_ws, size_t ws_size, hipStream_t stream) {
    static int grid = 0;
    if (grid == 0) {
        if (n_in != 24 || out_size != MTOK * DM || ws_size < WS_END) { fprintf(stderr, "kernel_launch: unexpected shapes (n_in %d out %d ws %zu)\n", n_in, out_size, ws_size); grid = -1; return; }
        int dev = 0, cus = 0, per_cu = 0;
        (void)hipGetDevice(&dev); (void)hipDeviceGetAttribute(&cus, hipDeviceAttributeMultiprocessorCount, dev);
        if (hipFuncSetAttribute((const void*)fwd_megakernel, hipFuncAttributeMaxDynamicSharedMemorySize, LDS_BYTES) != hipSuccess) fprintf(stderr, "kernel_launch: hipFuncSetAttribute failed\n");
        if (hipOccupancyMaxActiveBlocksPerMultiprocessor(&per_cu, (const void*)fwd_megakernel, 512, LDS_BYTES) != hipSuccess || per_cu < 1) { fprintf(stderr, "kernel_launch: occupancy query says %d\n", per_cu); per_cu = 1; }
        (void)hipGetLastError();
        if (cus <= 0) cus = 256;
        grid = cus;
    }
    if (grid < 0) return;
    Args a{};
    for (int i = 0; i < 24; ++i) a.in[i] = d_in[i];
    a.out = (float*)d_out; a.ws = (unsigned char*)d_ws;
    for (int i = 0; i < 16; ++i) a.invf[i] = (float)pow(500000.0, -(double)i / 16.0);
    (void)hipMemsetAsync((unsigned char*)d_ws + WS_BAR, 0, 16384, stream);
    void* args[] = {&a};
    hipError_t e = hipLaunchCooperativeKernel((const void*)fwd_megakernel, dim3(grid), dim3(512), args, LDS_BYTES, stream);
    if (e != hipSuccess) fprintf(stderr, "kernel_launch: cooperative launch failed: %s (grid %d)\n", hipGetErrorString(e), grid);
}
```

```cpp
#include <hip/hip_runtime.h>
#include <hip/hip_bf16.h>
#include <hip/hip_cooperative_groups.h>
#include <cstdio>
#include <cstdint>
#include <cmath>
namespace cg = cooperative_groups;
__device__ __forceinline__ int ltid() { int t = threadIdx.x; asm volatile("" : "+v"(t)); return t; }namespace pg8 {
#define PG8_LAS __attribute__((address_space(3)))
typedef unsigned short bf16_t;
typedef short bf16x8 __attribute__((ext_vector_type(8)));
typedef float f32x4 __attribute__((ext_vector_type(4)));
typedef unsigned u32x4 __attribute__((ext_vector_type(4)));
constexpr int BM = 256, BK = 64, HALF = 128, HTB = HALF * BK * 2  , STAGE_BYTES = 8 * HTB, NXCD = 8, WGM = 8;

__host__ __device__ __forceinline__ int lds_byte(int r, int c) { const int st = (r >> 4) * 2 + (c >> 5), rr = r & 15, cc = c & 31, ob = rr * 64 + cc * 2; return st * 1024 + (ob ^ (((ob >> 9) & 1) << 5)); }
__host__ __device__ __forceinline__ void stage_rc(int b, int& R, int& C) { const int st = b / 1024, sb = b % 1024, swz = sb ^ (((sb >> 9) & 1) << 5); R = (st >> 1) * 16 + swz / 64; C = (st & 1) * 32 + (swz % 64) / 2; }
__host__ __device__ __forceinline__ int perm32(int rho) { const int n = rho >> 4, i = rho & 15; return 8 * (i >> 2) + 4 * n + (i & 3); }

struct Unit { int pm, pn; };
struct Gemm { const bf16_t* A; const bf16_t* Bt; int M, N, K; };

struct StaticOrder {
    int nM, nN, nwg, G, c;
    __host__ __device__ void init(int M, int N, int G_, int c_) { nM = M / BM; nN = N / BM; nwg = nM * nN; G = G_; c = c_; }
    __host__ __device__ bool next(int i, Unit& u) const {
        const long L = (long)i * G + c; if (L >= nwg) return false;
        int wgid = (int)L; { const int q = nwg / NXCD, r = nwg % NXCD, xcd = wgid % NXCD, off = wgid / NXCD; wgid = (xcd < r ? xcd * (q + 1) : r * (q + 1) + (xcd - r) * q) + off; }
        const int nig = WGM * nN, gid = wgid / nig, fm = gid * WGM, gsz = (nM - fm) < WGM ? (nM - fm) : WGM;
        u.pm = fm + ((wgid % nig) % gsz); u.pn = (wgid % nig) / gsz; return true;
    }
    __device__ __forceinline__ void a_ready(const Unit&) const {}
    __device__ __forceinline__ void done(const Unit&) const {}
};
__device__ __forceinline__ unsigned cvt_pk_bf16(float lo, float hi) { unsigned r; asm volatile("v_cvt_pk_bf16_f32 %0, %1, %2" : "=v"(r) : "v"(lo), "v"(hi)); return r; }
struct MapOrder : StaticOrder {
    int split, off0, off1;
    __device__ __forceinline__ bool next(int i, Unit& u) const { if (!StaticOrder::next(i, u)) return false; u.pn += (u.pn < split) ? off0 : off1; return true; }
};
typedef unsigned u32x2 __attribute__((ext_vector_type(2)));
typedef float f32x2 __attribute__((ext_vector_type(2)));
__device__ __forceinline__ float rstd_of(float ss) { return rsqrtf(ss * (1.0f / 2048.0f) + 1e-6f); }
__device__ __forceinline__ float row_ss(const float* ssp, int row, int fq) {
    const f32x4 a = *(const f32x4*)(ssp + (size_t)row * 32 + fq * 8), b = *(const f32x4*)(ssp + (size_t)row * 32 + fq * 8 + 4);
    float s = ((a[0] + a[1]) + (a[2] + a[3])) + ((b[0] + b[1]) + (b[2] + b[3]));
    s += __shfl_xor(s, 16); s += __shfl_xor(s, 32); return s;
}
struct EpiScaleBf16 {
    static constexpr bool PERM = true, AFTER_DRAIN = false;
    bf16_t* O; int ldc; const float* ss; int nq; float qs;
    __device__ __forceinline__ void operator()(const f32x4 (&acc)[2][2][4][2], const Unit& u, int wr, int wc, int fr, int fq) const {
        const int row0 = u.pm * BM + wr * 64 + fr, col0 = u.pn * BM + wc * 32 + 8 * fq;
        const float sc = (u.pn < nq) ? qs : 1.f;
#pragma unroll
        for (int ai = 0; ai < 2; ++ai)
#pragma unroll
            for (int m = 0; m < 4; ++m) { const int row = row0 + ai * HALF + m * 16; const float rs = rstd_of(row_ss(ss, row, fq)) * sc; bf16_t* rowp = O + (size_t)row * ldc + col0;
#pragma unroll
                for (int bj = 0; bj < 2; ++bj) { const f32x4 v0 = acc[ai][bj][m][0] * rs, v1 = acc[ai][bj][m][1] * rs;
                    u32x4 w; w.x = cvt_pk_bf16(v0[0], v0[1]); w.y = cvt_pk_bf16(v0[2], v0[3]); w.z = cvt_pk_bf16(v1[0], v1[1]); w.w = cvt_pk_bf16(v1[2], v1[3]);
                    *(u32x4*)(rowp + bj * HALF) = w; } }
    }
};
struct EpiResid {
    static constexpr bool PERM = true, AFTER_DRAIN = false;
    const float* Rin; bf16_t* XB; float* ss;
    __device__ __forceinline__ void operator()(const f32x4 (&acc)[2][2][4][2], const Unit& u, int wr, int wc, int fr_in, int fq_in) const {
        int fr = fr_in, fq = fq_in; asm volatile("" : "+v"(fr), "+v"(fq));
        const int row0 = u.pm * BM + wr * 64 + fr, col0 = u.pn * BM + wc * 32 + 8 * fq;
#pragma unroll
        for (int ai = 0; ai < 2; ++ai) {
            u32x4 b[4][2];
#pragma unroll
            for (int m = 0; m < 4; ++m) { const size_t off = (size_t)(row0 + ai * HALF + m * 16) * 2048 + col0;
#pragma unroll
                for (int bj = 0; bj < 2; ++bj) b[m][bj] = *(const u32x4*)(XB + off + bj * HALF); }
#pragma unroll
            for (int m = 0; m < 4; ++m) { const int row = row0 + ai * HALF + m * 16; const size_t off = (size_t)row * 2048 + col0; float s = 0.f;
#pragma unroll
                for (int bj = 0; bj < 2; ++bj) { const u32x4 r = b[m][bj];
                    const f32x4 o0 = (f32x4){__uint_as_float(r.x << 16), __uint_as_float(r.x & 0xffff0000u), __uint_as_float(r.y << 16), __uint_as_float(r.y & 0xffff0000u)} + acc[ai][bj][m][0];
                    const f32x4 o1 = (f32x4){__uint_as_float(r.z << 16), __uint_as_float(r.z & 0xffff0000u), __uint_as_float(r.w << 16), __uint_as_float(r.w & 0xffff0000u)} + acc[ai][bj][m][1];
                    u32x4 w; w.x = cvt_pk_bf16(o0[0], o0[1]); w.y = cvt_pk_bf16(o0[2], o0[3]); w.z = cvt_pk_bf16(o1[0], o1[1]); w.w = cvt_pk_bf16(o1[2], o1[3]);
                    *(u32x4*)(XB + off + bj * HALF) = w;
                    s += ((o0[0] * o0[0] + o0[1] * o0[1]) + (o0[2] * o0[2] + o0[3] * o0[3])) + ((o1[0] * o1[0] + o1[1] * o1[1]) + (o1[2] * o1[2] + o1[3] * o1[3])); }
                s += __shfl_xor(s, 16); s += __shfl_xor(s, 32);
                if (fq == 0) ss[(size_t)row * 32 + u.pn * 4 + wc] = s; }
            asm volatile("" ::: "memory"); }
    }
};
struct EpiQKV {
    static constexpr bool PERM = false, AFTER_DRAIN = false;
    bf16_t* QH; const float* ss; const float* COS; const float* SIN;
    __device__ __forceinline__ void operator()(const f32x4 (&acc)[2][2][4][2], const Unit& u, int wr, int wc, int fr, int fq) const {
        const int kind = u.pn >> 3, hc0 = 2 * (u.pn & 7); const bool rope = (kind < 2) && (wc == 0);
        bf16_t* base = QH + (size_t)kind * ((size_t)8192 * 2048);
        const int row0 = u.pm * BM + wr * 64 + fr;
#pragma unroll
        for (int ai = 0; ai < 2; ++ai)
#pragma unroll
            for (int m = 0; m < 4; ++m) { const int row = row0 + ai * HALF + m * 16; const int b = row >> 11, s = row & 2047; const float rs = rstd_of(row_ss(ss, row, fq));
                f32x4 cs = (f32x4){1.f, 1.f, 1.f, 1.f}, sn = (f32x4){0.f, 0.f, 0.f, 0.f};
                if (rope) { cs = *(const f32x4*)(COS + (size_t)row * 16 + 4 * fq); sn = *(const f32x4*)(SIN + (size_t)row * 16 + 4 * fq); }
#pragma unroll
                for (int bj = 0; bj < 2; ++bj) { f32x4 v0 = acc[ai][bj][m][0] * rs, v1 = acc[ai][bj][m][1] * rs;
                    if (rope) { const f32x4 r0 = v0 * cs - v1 * sn, r1 = v1 * cs + v0 * sn; v0 = r0; v1 = r1; }
                    bf16_t* dst = base + ((size_t)(b * 16 + hc0 + bj) * 2048 + s) * 128 + wc * 32 + 4 * fq;
                    u32x2 w0, w1; w0.x = cvt_pk_bf16(v0[0], v0[1]); w0.y = cvt_pk_bf16(v0[2], v0[3]); w1.x = cvt_pk_bf16(v1[0], v1[1]); w1.y = cvt_pk_bf16(v1[2], v1[3]);
                    *(u32x2*)dst = w0; *(u32x2*)(dst + 16) = w1; } }
    }
};

struct EpiConvAct {
    static constexpr bool PERM = true, AFTER_DRAIN = false;
    bf16_t* ACT; bf16_t* USIDE; const float* ss; const float* cw; const float* cb;
    __device__ __forceinline__ void operator()(const f32x4 (&acc)[2][2][4][2], const Unit& u, int wr, int wc, int fr_in, int fq_in) const {
        int fr = fr_in, fq = fq_in; asm volatile("" : "+v"(fr), "+v"(fq));
        const int lane = fq * 16 + fr, f0 = 128 * u.pn + 32 * wc + 8 * fq;
        const int src1 = (lane & 48) | ((fr + 15) & 15), src2 = (lane & 48) | ((fr + 14) & 15);
        const int row0 = u.pm * BM + wr * 64 + fr;
        const bool side = (fr >= 14) || (fr < 2); const int slot = (fr >= 14) ? fr - 14 : fr + 2;
        u32x2 pk[2][2][4][2];
#pragma unroll
        for (int ai = 0; ai < 2; ++ai)
#pragma unroll
            for (int m = 0; m < 4; ++m) { const float rs = rstd_of(row_ss(ss, row0 + ai * HALF + m * 16, fq));
#pragma unroll
                for (int bj = 0; bj < 2; ++bj)
#pragma unroll
                    for (int n = 0; n < 2; ++n) { const f32x4 v = acc[ai][bj][m][n] * rs; pk[ai][bj][m][n].x = cvt_pk_bf16(v[0], v[1]); pk[ai][bj][m][n].y = cvt_pk_bf16(v[2], v[3]); } }
        __builtin_amdgcn_sched_barrier(0);
        const bool l15 = (fr == 15), l14 = (fr >= 14);
#define CV_ROR(x, n_) ((unsigned)__builtin_amdgcn_update_dpp(0, (int)(x), 0x120 + (n_), 0xF, 0xF, false))
#define CV_UNPK(w) ((f32x2){__uint_as_float((w) << 16), __uint_as_float((w) & 0xffff0000u)})
#pragma unroll
        for (int ai = 0; ai < 2; ++ai) { u32x4 ow4[4];
#pragma unroll
            for (int n = 0; n < 2; ++n) { const int f = f0 + 4 * n;
                const f32x4 wg0 = *(const f32x4*)(cw + f), wg1 = *(const f32x4*)(cw + 11264 + f), wg2 = *(const f32x4*)(cw + 22528 + f), bg = *(const f32x4*)(cb + f);
                const f32x4 wv0 = *(const f32x4*)(cw + 5632 + f), wv1 = *(const f32x4*)(cw + 11264 + 5632 + f), wv2 = *(const f32x4*)(cw + 22528 + 5632 + f), bv = *(const f32x4*)(cb + 5632 + f);
                u32x2 ow[4];
#pragma unroll
                for (int h = 0; h < 2; ++h) {
                    const f32x2 g0 = {wg0[2 * h], wg0[2 * h + 1]}, g1 = {wg1[2 * h], wg1[2 * h + 1]}, g2 = {wg2[2 * h], wg2[2 * h + 1]}, gb = {bg[2 * h], bg[2 * h + 1]};
                    const f32x2 v0 = {wv0[2 * h], wv0[2 * h + 1]}, v1 = {wv1[2 * h], wv1[2 * h + 1]}, v2 = {wv2[2 * h], wv2[2 * h + 1]}, vb = {bv[2 * h], bv[2 * h + 1]};
#pragma unroll
                    for (int m = 0; m < 4; ++m) { const int mp = m > 0 ? m - 1 : 0;
                        const unsigned Wg = h ? pk[ai][0][m][n].y : pk[ai][0][m][n].x, Wgp = h ? pk[ai][0][mp][n].y : pk[ai][0][mp][n].x;
                        const unsigned Wv = h ? pk[ai][1][m][n].y : pk[ai][1][m][n].x, Wvp = h ? pk[ai][1][mp][n].y : pk[ai][1][mp][n].x;
                        const unsigned s1g = CV_ROR(l15 ? Wgp : Wg, 1), s2g = CV_ROR(l14 ? Wgp : Wg, 2), s1v = CV_ROR(l15 ? Wvp : Wv, 1), s2v = CV_ROR(l14 ? Wvp : Wv, 2);
                        const f32x2 g = gb + g0 * CV_UNPK(s2g) + g1 * CV_UNPK(s1g) + g2 * CV_UNPK(Wg);
                        const f32x2 v = vb + v0 * CV_UNPK(s2v) + v1 * CV_UNPK(s1v) + v2 * CV_UNPK(Wv);
                        f32x2 r; r.x = __builtin_amdgcn_rcpf(1.f + __builtin_amdgcn_exp2f(g.x * -1.44269504f)); r.y = __builtin_amdgcn_rcpf(1.f + __builtin_amdgcn_exp2f(g.y * -1.44269504f));
                        const f32x2 o = g * r * v; const unsigned w = cvt_pk_bf16(o.x, o.y); if (h) ow[m].y = w; else ow[m].x = w; } }
#pragma unroll
                for (int m = 0; m < 4; ++m) { if (n == 0) { ow4[m].x = ow[m].x; ow4[m].y = ow[m].y; } else { ow4[m].z = ow[m].x; ow4[m].w = ow[m].y; } }
                if (side) { const int k = 4 * u.pm + 2 * ai + wr; bf16_t* sp = USIDE + (size_t)(k * 4 + slot) * 11264 + f;
                    *(u32x2*)sp = (fr >= 8) ? pk[ai][0][3][n] : pk[ai][0][0][n]; *(u32x2*)(sp + 5632) = (fr >= 8) ? pk[ai][1][3][n] : pk[ai][1][0][n]; }
                __builtin_amdgcn_sched_barrier(0); }
#pragma unroll
            for (int m = 0; m < 4; ++m) { if (!(m == 0 && fr < 2)) *(u32x4*)(ACT + (size_t)(row0 + ai * HALF + m * 16) * 5632 + f0) = ow4[m]; }
            asm volatile("" ::: "memory"); }
#undef CV_ROR
#undef CV_UNPK
    }
};
template <class Epi, class Sched, bool ALIGN_EPI = false, bool SP2 = false>
__device__ __forceinline__ void gemm_phase(PG8_LAS unsigned char* lds, const Gemm g, const Sched& S, const Epi& E) {
    const int tid = ltid(), wid = __builtin_amdgcn_readfirstlane(tid >> 6), lane = tid & 63, wr = wid >> 2, wc = wid & 3, fr = lane & 15, fq = lane >> 4;
    const int K = g.K, nt = K / BK;
    unsigned voffA[2], voffB[2];
#pragma unroll
    for (int i = 0; i < 2; ++i) { int R, C; stage_rc(tid * 16 + i * 8192, R, C); const int Rb = Epi::PERM ? ((R & ~31) + perm32(R & 31)) : R;
        voffA[i] = (unsigned)(R * K + C) * 2u; voffB[i] = (unsigned)(Rb * K + C) * 2u; }
    const size_t kstep = (size_t)(BK * 2);
    const size_t hstep = (size_t)HALF * K * 2;
    const size_t tstep = 2 * hstep;
    const unsigned ldsw = (unsigned)wid * 1024u;
    const int aoff = lds_byte(wr * 64 + fr, fq * 8), boff = lds_byte(wc * 32 + fr, fq * 8);
#define PG8_SA(b, h) (((b) * 2 + (h)) * HTB)
#define PG8_SB(b, h) ((4 + (b) * 2 + (h)) * HTB)
#define PG8_STAGE(bufoff, gbase, voff) do { _Pragma("unroll") for (int _i = 0; _i < 2; ++_i) \
        __builtin_amdgcn_global_load_lds((const unsigned*)((const char*)(gbase) + (voff)[_i]), (PG8_LAS unsigned*)(lds + (bufoff) + ldsw + _i * 8192), 16, 0, 0); } while (0)
#define PG8_LDA(dst, b, h) do { _Pragma("unroll") for (int m = 0; m < 4; ++m) _Pragma("unroll") for (int k = 0; k < 2; ++k) dst[m][k] = *(const PG8_LAS bf16x8*)(lds + PG8_SA(b, h) + aoff + m * 2048 + k * 1024); } while (0)
#define PG8_LDB(dst, b, h) do { _Pragma("unroll") for (int n = 0; n < 2; ++n) _Pragma("unroll") for (int k = 0; k < 2; ++k) dst[n][k] = *(const PG8_LAS bf16x8*)(lds + PG8_SB(b, h) + boff + n * 2048 + k * 1024); } while (0)
#define PG8_MMA(ai, bj, At, Bt) do { __builtin_amdgcn_s_setprio(1); _Pragma("unroll") for (int m = 0; m < 4; ++m) _Pragma("unroll") for (int n = 0; n < 2; ++n) _Pragma("unroll") for (int k = 0; k < 2; ++k) \
        acc[ai][bj][m][n] = __builtin_amdgcn_mfma_f32_16x16x32_bf16(Bt[n][k], At[m][k], acc[ai][bj][m][n], 0, 0, 0); __builtin_amdgcn_s_setprio(0); } while (0)
#define PG8_WAIT_V(n) asm volatile("s_waitcnt vmcnt(" #n ")" ::: "memory")
#define PG8_WAIT_L(n) asm volatile("s_waitcnt lgkmcnt(" #n ")" ::: "memory")
#define PG8_BAR __builtin_amdgcn_s_barrier()
#define PG8_SCHED __builtin_amdgcn_sched_barrier(0)
    Unit cur, nxt; int ui = 0;
    if (!S.next(0, cur)) return;
    f32x4 acc[2][2][4][2];
#pragma unroll
    for (int a = 0; a < 2; ++a)
#pragma unroll
        for (int b = 0; b < 2; ++b)
#pragma unroll
            for (int m = 0; m < 4; ++m)
#pragma unroll
                for (int n = 0; n < 2; ++n) acc[a][b][m][n] = (f32x4){0.f, 0.f, 0.f, 0.f};
    bf16x8 At[4][2], B0[2][2], B1[2][2];
    const char* cA = (const char*)g.A + (size_t)cur.pm * tstep; const char* cB = (const char*)g.Bt + (size_t)cur.pn * tstep;
    S.a_ready(cur);
    if constexpr (SP2) {
        PG8_STAGE(PG8_SB(0, 0), cB, voffB); PG8_STAGE(PG8_SB(0, 1), cB + hstep, voffB); PG8_STAGE(PG8_SA(0, 0), cA, voffA); PG8_STAGE(PG8_SA(0, 1), cA + hstep, voffA);
        if (wr == 1) PG8_BAR;
        PG8_WAIT_V(2); PG8_BAR;
        PG8_STAGE(PG8_SB(1, 0), cB + kstep, voffB); PG8_STAGE(PG8_SA(1, 0), cA + kstep, voffA); PG8_STAGE(PG8_SB(1, 1), cB + hstep + kstep, voffB);
        PG8_WAIT_V(6); PG8_BAR;
    } else {
        PG8_STAGE(PG8_SB(0, 0), cB, voffB); PG8_STAGE(PG8_SA(0, 0), cA, voffA); PG8_STAGE(PG8_SB(0, 1), cB + hstep, voffB); PG8_STAGE(PG8_SA(0, 1), cA + hstep, voffA);
        if (wr == 1) PG8_BAR;
        PG8_WAIT_V(4); PG8_BAR;
        PG8_STAGE(PG8_SB(1, 0), cB + kstep, voffB); PG8_STAGE(PG8_SA(1, 0), cA + kstep, voffA); PG8_STAGE(PG8_SB(1, 1), cB + hstep + kstep, voffB);
        PG8_WAIT_V(6); PG8_BAR;
    }
    for (;;) {
        const bool has_next = S.next(ui + 1, nxt);
        const char* nA = has_next ? (const char*)g.A + (size_t)nxt.pm * tstep : cA; const char* nB = has_next ? (const char*)g.Bt + (size_t)nxt.pn * tstep : cB;
        for (int t = 0; t < nt; t += 2) {
            const bool last = (t == nt - 2);
            const char* a1 = cA + (size_t)(t + 1) * kstep;
            const char* a2 = last ? nA : cA + (size_t)(t + 2) * kstep; const char* b2 = last ? nB : cB + (size_t)(t + 2) * kstep;
            const char* a3 = a2 + kstep; const char* b3 = b2 + kstep;
            if (last && has_next) S.a_ready(nxt);
            if constexpr (SP2) {
            PG8_LDB(B0, 0, 0); PG8_LDB(B1, 0, 1); PG8_SCHED; PG8_LDA(At, 0, 0); PG8_STAGE(PG8_SA(1, 1), a1 + hstep, voffA);
            PG8_WAIT_V(8); PG8_WAIT_L(0); PG8_BAR; PG8_MMA(0, 0, At, B0); PG8_MMA(0, 1, At, B1); PG8_BAR; PG8_SCHED;
            PG8_LDA(At, 0, 1); PG8_STAGE(PG8_SB(0, 0), b2, voffB); PG8_STAGE(PG8_SB(0, 1), b2 + hstep, voffB); PG8_STAGE(PG8_SA(0, 0), a2, voffA);
            PG8_WAIT_V(8); PG8_WAIT_L(0); PG8_BAR; PG8_MMA(1, 0, At, B0); PG8_MMA(1, 1, At, B1); PG8_BAR; PG8_SCHED;
            PG8_LDB(B0, 1, 0); PG8_LDB(B1, 1, 1); PG8_SCHED; PG8_LDA(At, 1, 0); PG8_STAGE(PG8_SA(0, 1), a2 + hstep, voffA);
            PG8_WAIT_V(8); PG8_WAIT_L(0); PG8_BAR; PG8_MMA(0, 0, At, B0); PG8_MMA(0, 1, At, B1); PG8_BAR; PG8_SCHED;
            PG8_LDA(At, 1, 1); PG8_STAGE(PG8_SB(1, 0), b3, voffB); PG8_STAGE(PG8_SB(1, 1), b3 + hstep, voffB); PG8_STAGE(PG8_SA(1, 0), a3, voffA);
            PG8_WAIT_V(8); PG8_WAIT_L(0); PG8_BAR; PG8_MMA(1, 0, At, B0); PG8_MMA(1, 1, At, B1); PG8_BAR; PG8_SCHED;
            } else {
            PG8_LDB(B0, 0, 0); PG8_SCHED; PG8_LDA(At, 0, 0); PG8_STAGE(PG8_SA(1, 1), a1 + hstep, voffA);
            PG8_WAIT_L(8); PG8_BAR; PG8_WAIT_L(0); PG8_MMA(0, 0, At, B0); PG8_BAR; PG8_SCHED;
            PG8_LDB(B1, 0, 1); PG8_STAGE(PG8_SB(0, 0), b2, voffB);
            PG8_BAR; PG8_WAIT_L(0); PG8_MMA(0, 1, At, B1); PG8_BAR;
            PG8_LDA(At, 0, 1); PG8_STAGE(PG8_SA(0, 0), a2, voffA);
            PG8_BAR; PG8_WAIT_L(0); PG8_MMA(1, 0, At, B0); PG8_BAR; PG8_SCHED;
            PG8_STAGE(PG8_SB(0, 1), b2 + hstep, voffB);
            PG8_WAIT_V(6); PG8_BAR; PG8_MMA(1, 1, At, B1); PG8_BAR;
            PG8_LDB(B0, 1, 0); PG8_SCHED; PG8_LDA(At, 1, 0); PG8_STAGE(PG8_SA(0, 1), a2 + hstep, voffA);
            PG8_WAIT_L(8); PG8_BAR; PG8_WAIT_L(0); PG8_MMA(0, 0, At, B0); PG8_BAR; PG8_SCHED;
            PG8_LDB(B1, 1, 1); PG8_STAGE(PG8_SB(1, 0), b3, voffB);
            PG8_BAR; PG8_WAIT_L(0); PG8_MMA(0, 1, At, B1); PG8_BAR;
            PG8_LDA(At, 1, 1); PG8_STAGE(PG8_SA(1, 0), a3, voffA);
            PG8_BAR; PG8_WAIT_L(0); PG8_MMA(1, 0, At, B0); PG8_BAR; PG8_SCHED;
            PG8_STAGE(PG8_SB(1, 1), b3 + hstep, voffB);
            PG8_WAIT_V(6); PG8_BAR; PG8_MMA(1, 1, At, B1); PG8_BAR;
            }
        }
        if constexpr (ALIGN_EPI) { if (wr == 0) PG8_BAR; }
        if constexpr (!Epi::AFTER_DRAIN) { E(acc, cur, wr, wc, fr, fq); S.done(cur); }
        if (!has_next) break;
#pragma unroll
        for (int a = 0; a < 2; ++a)
#pragma unroll
            for (int b = 0; b < 2; ++b)
#pragma unroll
                for (int m = 0; m < 4; ++m)
#pragma unroll
                    for (int n = 0; n < 2; ++n) acc[a][b][m][n] = (f32x4){0.f, 0.f, 0.f, 0.f};
        cur = nxt; cA = nA; cB = nB; ++ui;
        if constexpr (ALIGN_EPI) { if (wr == 1) PG8_BAR; }
    }
    PG8_WAIT_V(0);
    if constexpr (!ALIGN_EPI) { if (wr == 0) PG8_BAR; }
    PG8_BAR;
    if constexpr (Epi::AFTER_DRAIN) { E.fused(acc, cur, wr, wc, fr, fq, lds, wid, lane); S.done(cur); }
#undef PG8_SA
#undef PG8_SB
#undef PG8_STAGE
#undef PG8_LDA
#undef PG8_LDB
#undef PG8_MMA
#undef PG8_WAIT_V
#undef PG8_WAIT_L
#undef PG8_BAR
#undef PG8_SCHED
}
}
namespace attn {
constexpr int D = 128; constexpr bool WSKIP = false; constexpr float THR = 8.f;
constexpr float SCALE = 0.08838834764831845f;
constexpr int NW = 8, QBLK = 32, KVBLK = 64, QB = NW * QBLK;
constexpr int SHM_V = KVBLK * D * 2, SHM_K = KVBLK * D * 2;
constexpr int LDS_BYTES = 2 * SHM_V + 2 * SHM_K + NW * 64 * 4;

using bf16 = __hip_bfloat16;
typedef short bf16x8 __attribute__((ext_vector_type(8)));
typedef short s16x4 __attribute__((ext_vector_type(4)));
typedef float f32x16 __attribute__((ext_vector_type(16)));
typedef float f32x4 __attribute__((ext_vector_type(4)));
typedef unsigned u32x4 __attribute__((ext_vector_type(4)));
template <class A, class Bt> struct same_t { static constexpr bool v = false; };
template <class A> struct same_t<A, A> { static constexpr bool v = true; };

#define KSWZ(row, colB) ((row) * 256 + ((colB) ^ (((row) & 7) << 4)))
#define SBAR() __builtin_amdgcn_sched_barrier(0)
__device__ __forceinline__ int v_st(int k, int c) { const int kk = (k & ~0xC) | ((k & 4) << 1) | ((k & 8) >> 1); return ((kk >> 3) * 4 + (c >> 5)) * 512 + ((kk & 7) * 32 + (c & 31)) * 2; }
__device__ __forceinline__ int v_rd_base(int lane) { return ((lane & 3) << 3) | (((lane >> 2) & 3) << 6) | (((lane >> 4) & 1) << 5) | (((lane >> 5) & 1) << 8); }
constexpr int v_rd_off(int d0, int ks, int half) { return d0 * 512 + ks * 4096 + half * 2048; }
__device__ __forceinline__ int crow(int r, int hi) { return (r & 3) + 8 * (r >> 2) + 4 * hi; }
__device__ __forceinline__ unsigned cvtpk(float lo, float hi) {
    unsigned r; asm volatile("v_cvt_pk_bf16_f32 %0, %1, %2" : "=v"(r) : "v"(lo), "v"(hi)); return r;
}
__device__ __forceinline__ bf16x8 pack8(f32x4 a, f32x4 b) {
    u32x4 w = {cvtpk(a[0], a[1]), cvtpk(a[2], a[3]), cvtpk(b[0], b[1]), cvtpk(b[2], b[3])};
    return *reinterpret_cast<bf16x8*>(&w);
}
template <class T> __device__ __forceinline__ bf16x8 load8(const T* p) {
    if constexpr (same_t<T, float>::v) { return pack8(*(const f32x4*)p, *(const f32x4*)(p + 4)); }
    else { return *reinterpret_cast<const bf16x8*>(p); }
}
__device__ __forceinline__ void mask_tile(f32x16& p0, f32x16& p1, int dq, unsigned W) {
    const float NEG = -__builtin_inff();
#pragma unroll
    for (int r = 0; r < 16; ++r) {
        const int c = (r & 3) + 8 * (r >> 2);
        if ((unsigned)(dq - c) >= W) p0[r] = NEG;
        if ((unsigned)(dq - c - 32) >= W) p1[r] = NEG;
    }
}
__device__ __forceinline__ void partialSM(f32x16& p0, f32x16& p1, float& m_reg, float& mn, float& alpha) {
    float pmax = p0[0]; for (int r = 1; r < 16; ++r) pmax = fmaxf(pmax, p0[r]); for (int r = 0; r < 16; ++r) pmax = fmaxf(pmax, p1[r]);
    { auto rr = __builtin_amdgcn_permlane32_swap(__float_as_uint(pmax), __float_as_uint(pmax), false, false);
      pmax = fmaxf(__uint_as_float(rr[0]), __uint_as_float(rr[1])); }
    constexpr float C2 = 1.4426950408889634f * SCALE;
    if (__builtin_expect(__all((pmax - m_reg) * SCALE <= THR), 1)) { mn = m_reg; alpha = 1.f; }
    else { mn = fmaxf(m_reg, pmax); alpha = __builtin_amdgcn_exp2f((m_reg - mn) * C2); m_reg = mn; }
    const float mnL = -mn * C2;
    for (int r = 0; r < 16; ++r) p0[r] = fmaf(p0[r], C2, mnL); for (int r = 0; r < 16; ++r) p1[r] = fmaf(p1[r], C2, mnL);
    for (int r = 0; r < 16; ++r) p0[r] = __builtin_amdgcn_exp2f(p0[r]);
}
__device__ __forceinline__ void finishSM(f32x16& p0, f32x16& p1, float alpha, float& l_reg, bf16x8& pa0, bf16x8& pa1, bf16x8& pa2, bf16x8& pa3) {
    for (int r = 0; r < 16; ++r) p1[r] = __builtin_amdgcn_exp2f(p1[r]);
    float ps = 0; for (int r = 0; r < 16; ++r) ps += p0[r]; for (int r = 0; r < 16; ++r) ps += p1[r];
    { auto rr = __builtin_amdgcn_permlane32_swap(__float_as_uint(ps), __float_as_uint(ps), false, false);
      ps = __uint_as_float(rr[0]) + __uint_as_float(rr[1]); }
    l_reg = l_reg * alpha + ps;
#define PK4(P, B_, OUT) do { unsigned a0 = cvtpk(P[B_+0], P[B_+1]), a1 = cvtpk(P[B_+2], P[B_+3]);                          \
        unsigned b0 = cvtpk(P[B_+4], P[B_+5]), b1 = cvtpk(P[B_+6], P[B_+7]);                                             \
        auto r0 = __builtin_amdgcn_permlane32_swap(a0, b0, false, false); auto r1 = __builtin_amdgcn_permlane32_swap(a1, b1, false, false); \
        u32x4 w = {r0[0], r1[0], r0[1], r1[1]}; OUT = *reinterpret_cast<bf16x8*>(&w); } while (0)
    PK4(p0, 0, pa0); PK4(p0, 8, pa1); PK4(p1, 0, pa2); PK4(p1, 8, pa3);
#undef PK4
}
template <int KB, bool SK>
__device__ __forceinline__ void qkt(f32x16& p0, f32x16& p1, const char* K_lds, int r32, int hi, const bf16x8* qr, bool act) {
    if (SK && !act) { const float NEG = -__builtin_inff();
#pragma unroll
        for (int r = 0; r < 16; ++r) { p0[r] = NEG; p1[r] = NEG; } return; }
    p0 = f32x16{}; p1 = f32x16{};
    const char* kb[4];
#pragma unroll
    for (int dd = 0; dd < 4; ++dd) kb[dd] = K_lds + KB * SHM_K + KSWZ(r32, (dd * 16 + hi * 8) * 2);
#pragma unroll
    for (int d0 = 0; d0 < 8; ++d0) { const char* a = kb[d0 & 3] + (d0 >> 2) * 128;
        bf16x8 b0 = *reinterpret_cast<const bf16x8*>(a);
        bf16x8 b1 = *reinterpret_cast<const bf16x8*>(a + 32 * 256);
        p0 = __builtin_amdgcn_mfma_f32_32x32x16_bf16(b0, qr[d0], p0, 0, 0, 0);
        p1 = __builtin_amdgcn_mfma_f32_32x32x16_bf16(b1, qr[d0], p1, 0, 0, 0); }
}
template <int VB, bool SK>
__device__ __forceinline__ void pv_tile(f32x16* o, int vb0, bf16x8 pa0, bf16x8 pa1, bf16x8 pa2, bf16x8 pa3, bool act) {
    if (SK && !act) return;
#define TRRD(dst, off) asm volatile("ds_read_b64_tr_b16 %0, %1 offset:%2" : "=&v"(dst) : "v"(vb0), "i"(off) : "memory")
#define PV_D0(d0) do { s16x4 l0, l1, l2, l3, h0, h1, h2, h3; constexpr int b_ = VB * SHM_V + v_rd_off(d0, 0, 0);     \
        TRRD(l0, b_); TRRD(h0, b_ + 2048); TRRD(l1, b_ + 4096); TRRD(h1, b_ + 6144); TRRD(l2, b_ + 8192); TRRD(h2, b_ + 10240); TRRD(l3, b_ + 12288); TRRD(h3, b_ + 14336); \
        asm volatile("s_waitcnt lgkmcnt(0)" ::: "memory"); SBAR();                 \
        o[d0] = __builtin_amdgcn_mfma_f32_32x32x16_bf16(pa0, (bf16x8){l0[0], l0[1], l0[2], l0[3], h0[0], h0[1], h0[2], h0[3]}, o[d0], 0, 0, 0);   \
        o[d0] = __builtin_amdgcn_mfma_f32_32x32x16_bf16(pa1, (bf16x8){l1[0], l1[1], l1[2], l1[3], h1[0], h1[1], h1[2], h1[3]}, o[d0], 0, 0, 0);   \
        o[d0] = __builtin_amdgcn_mfma_f32_32x32x16_bf16(pa2, (bf16x8){l2[0], l2[1], l2[2], l2[3], h2[0], h2[1], h2[2], h2[3]}, o[d0], 0, 0, 0);   \
        o[d0] = __builtin_amdgcn_mfma_f32_32x32x16_bf16(pa3, (bf16x8){l3[0], l3[1], l3[2], l3[3], h3[0], h3[1], h3[2], h3[3]}, o[d0], 0, 0, 0); } while (0)
    PV_D0(0); PV_D0(1); PV_D0(2); PV_D0(3);
#undef PV_D0
#undef TRRD
}

template <class TIn, class TOut> struct BlockRef { const TIn* Q; const TIn* K; const TIn* V; TOut* O; int P0; };
template <class TIn> struct Seam {
    bf16x8 qr[8];
    bf16x8 st_v0, st_v1, st_k0, st_k1; f32x4 sf0, sf1, sf2, sf3;
    f32x4 tq[16];
};
__device__ __forceinline__ int swa_jlo(int P0, int W) { const int lowk = P0 - W + 1; return lowk > 0 ? lowk / KVBLK : 0; }
#define ROW(p, k0, rr) ((p) + (size_t)((k0) + (rr)) * D + sc)
#define VMW() asm volatile("s_waitcnt vmcnt(0)" ::: "memory")
#define VMWN(n) asm volatile("s_waitcnt vmcnt(%0)" :: "i"(n) : "memory")
#define SLOAD_H(Kp, Vp, k0) do { S.st_v0 = load8<TIn>(ROW(Vp, k0, sr)); S.st_v1 = load8<TIn>(ROW(Vp, k0, 32 + sr));              \
                         S.st_k0 = load8<TIn>(ROW(Kp, k0, sr)); S.st_k1 = load8<TIn>(ROW(Kp, k0, 32 + sr)); } while (0)
#define SWRITE_HK(bf) do { *(bf16x8*)(K_lds + (bf) * SHM_K + kws) = S.st_k0; *(bf16x8*)(K_lds + (bf) * SHM_K + kws + 32 * 256) = S.st_k1; } while (0)
#define SWRITE_HV(bf) do { *(bf16x8*)(V_lds + (bf) * SHM_V + vst0) = S.st_v0; *(bf16x8*)(V_lds + (bf) * SHM_V + vst1) = S.st_v1; } while (0)
#define SWRITE_H(bf) do { SWRITE_HV(bf); SWRITE_HK(bf); } while (0)
#define SLOAD_F(p, k0) do { S.sf0 = *(const f32x4*)ROW(p, k0, sr); S.sf1 = *(const f32x4*)(ROW(p, k0, sr) + 4);                \
                            S.sf2 = *(const f32x4*)ROW(p, k0, 32 + sr); S.sf3 = *(const f32x4*)(ROW(p, k0, 32 + sr) + 4); } while (0)
#define SWRITE_KF(bf) do { *(bf16x8*)(K_lds + (bf) * SHM_K + kws) = pack8(S.sf0, S.sf1); *(bf16x8*)(K_lds + (bf) * SHM_K + kws + 32 * 256) = pack8(S.sf2, S.sf3); } while (0)
#define SWRITE_VF(bf) do { *(bf16x8*)(V_lds + (bf) * SHM_V + vst0) = pack8(S.sf0, S.sf1); *(bf16x8*)(V_lds + (bf) * SHM_V + vst1) = pack8(S.sf2, S.sf3); } while (0)
template <class TIn, class TOut>
__device__ __forceinline__ void causal_swa_prime(const BlockRef<TIn, TOut>& cur, int W, char* lds, Seam<TIn>& S) {
    constexpr bool F32 = same_t<TIn, float>::v;
    const int tid = ltid(), wid = __builtin_amdgcn_readfirstlane(tid >> 6), lane = tid & 63, r32 = lane & 31, hi = lane >> 5;
    const int sr = tid >> 4, sc = (tid & 15) * 8, kws = KSWZ(sr, sc * 2); char* K_lds = lds + 2 * SHM_V;
    const int kb0 = swa_jlo(cur.P0, W) * KVBLK;
    for (int d0 = 0; d0 < 8; ++d0) S.qr[d0] = load8<TIn>(cur.Q + (size_t)(wid * QBLK + r32) * D + d0 * 16 + hi * 8);
    if constexpr (F32) { SLOAD_F((const float*)cur.K, kb0); VMW(); SWRITE_KF(0); SBAR(); SLOAD_F((const float*)cur.V, kb0); }
    else { SLOAD_H(cur.K, cur.V, kb0); VMW(); SWRITE_HK(0); }
    __syncthreads();
}
template <class TIn, class TOut>
__device__ __forceinline__ void causal_swa_block(const BlockRef<TIn, TOut>& cur, const BlockRef<TIn, TOut>& nxt, int skv, int W, char* lds, Seam<TIn>& S) {
    constexpr bool F32 = same_t<TIn, float>::v;
    const int tid = ltid(), wid = __builtin_amdgcn_readfirstlane(tid >> 6), lane = tid & 63, r32 = lane & 31, hi = lane >> 5;
    const int j_lo = swa_jlo(cur.P0, W);
    int j_hi = (cur.P0 + QB - 1) / KVBLK + 1; if (j_hi > skv / KVBLK) j_hi = skv / KVBLK;
    const int NT = j_hi - j_lo;
    const int kbn = swa_jlo(nxt.P0, W) * KVBLK;
    const int qlo = cur.P0 + wid * QBLK, qm = qlo + r32 - 4 * hi;
    char* V_lds = lds; char* K_lds = lds + 2 * SHM_V;
    float* ws = (float*)(lds + 2 * SHM_V + 2 * SHM_K) + wid * 64; float* li_l = ws, * al_l = ws + 32;
    float m_reg = -1e30f, l_reg = 0; f32x16 o[4] = {};
    const int sr = tid >> 4, sc = (tid & 15) * 8, vst0 = v_st(sr, sc), vst1 = v_st(32 + sr, sc), kws = KSWZ(sr, sc * 2);
    const int vb0 = (int)(uintptr_t)V_lds + v_rd_base(lane);
    const TIn* Kh = cur.K; const TIn* Vh = cur.V;
#define RESC(a) do { if (__any((a) < 1.f)) { if (hi == 0) al_l[r32] = (a); asm volatile("s_waitcnt lgkmcnt(0)" ::: "memory");              \
                     for (int d_ = 0; d_ < 4; ++d_) for (int r = 0; r < 16; ++r) o[d_][r] *= al_l[crow(r, hi)]; } } while (0)
#define KBASE(t) ((j_lo + (t)) * KVBLK)
#define ACT(t) (KBASE(t) <= qlo + QBLK - 1 && KBASE(t) + KVBLK - 1 >= qlo - W + 1)
#define MASKT(P0_, P1_, t) do { const int kb_ = KBASE(t); if ((!SK || ACT(t)) && (kb_ + KVBLK - 1 > qlo || kb_ <= qlo + QBLK - 1 - W)) mask_tile(P0_, P1_, qm - kb_, (unsigned)W); } while (0)
    constexpr int NQL = F32 ? 16 : 8;
    constexpr bool SK = WSKIP && !F32;
#define SEAM_K0() do { VMWN(NQL); if constexpr (F32) { SWRITE_KF(0); SBAR(); SLOAD_F((const float*)nxt.V, kbn); } else { SWRITE_HK(0); } SBAR(); } while (0)
    f32x16 pA0, pA1, pB0, pB1; float mnA, mnB, alA, alB; bf16x8 pa0, pa1, pa2, pa3;
    if constexpr (F32) { VMW(); SWRITE_VF(0); SBAR(); } else { SWRITE_HV(0); SBAR(); }
    if (NT > 1) { if constexpr (F32) SLOAD_F((const float*)Kh, KBASE(1)); else SLOAD_H(Kh, Vh, KBASE(1)); }
    SBAR(); qkt<0, SK>(pA0, pA1, K_lds, r32, hi, S.qr, ACT(0));
    if constexpr (F32) { if (NT > 1) { VMW(); SWRITE_KF(1); SBAR(); SLOAD_F((const float*)Vh, KBASE(1)); } }
    MASKT(pA0, pA1, 0); partialSM(pA0, pA1, m_reg, mnA, alA);
    if (NT > 1) { VMW(); if constexpr (F32) { SWRITE_VF(1); SBAR(); if (NT > 2) SLOAD_F((const float*)Kh, KBASE(2)); } else SWRITE_H(1); }
    __syncthreads();
#define HALF_STEP(PX0, PX1, mnX, alX, PY0, PY1, alY, t, KB, VB, SB) do {                                                      \
        SBAR(); qkt<KB, SK>(PX0, PX1, K_lds, r32, hi, S.qr, ACT(t));                                             \
        finishSM(PY0, PY1, alY, l_reg, pa0, pa1, pa2, pa3); SBAR();                                                           \
        if ((t) + 1 < NT) { if constexpr (F32) { VMW(); SWRITE_KF(SB); SBAR(); SLOAD_F((const float*)Vh, KBASE((t) + 1)); }  \
                            else { SLOAD_H(Kh, Vh, KBASE((t) + 1)); } SBAR(); }                                               \
        pv_tile<VB, SK>(o, vb0, pa0, pa1, pa2, pa3, ACT((t) - 1)); MASKT(PX0, PX1, (t)); partialSM(PX0, PX1, m_reg, mnX, alX);                                        \
        __syncthreads();                                                                                                      \
        if ((t) + 1 < NT) { VMW(); if constexpr (F32) { SWRITE_VF(SB); SBAR(); if ((t) + 2 < NT) SLOAD_F((const float*)Kh, KBASE((t) + 2)); } \
                            else { SWRITE_H(SB); } }                                                                          \
        RESC(alX); __syncthreads(); } while (0)
    for (int t = 1; t + 1 < NT; t += 2) {
        HALF_STEP(pB0, pB1, mnB, alB, pA0, pA1, alA, t, 1, 0, 0);
        HALF_STEP(pA0, pA1, mnA, alA, pB0, pB1, alB, t + 1, 0, 1, 1);
    }
    const bool even = (NT & 1) == 0;
    if (even) { SBAR(); qkt<1, SK>(pB0, pB1, K_lds, r32, hi, S.qr, ACT(NT - 1)); SBAR(); }
#define QROW(e) (nxt.Q + (size_t)(wid * QBLK + r32) * D + ((e) >> 1) * 16 + hi * 8 + ((e) & 1) * 4)
    if constexpr (F32) { SLOAD_F((const float*)nxt.K, kbn); SBAR();
#pragma unroll
        for (int e = 0; e < 8; ++e) S.tq[e] = *(const f32x4*)QROW(e); }
    else { SLOAD_H(nxt.K, nxt.V, kbn); SBAR();
#pragma unroll
        for (int d0 = 0; d0 < 8; ++d0) S.qr[d0] = load8<TIn>(nxt.Q + (size_t)(wid * QBLK + r32) * D + d0 * 16 + hi * 8); }
    SBAR();
    finishSM(pA0, pA1, alA, l_reg, pa0, pa1, pa2, pa3); SBAR();
    if constexpr (F32) {
#pragma unroll
        for (int e = 8; e < 16; ++e) S.tq[e] = *(const f32x4*)QROW(e); SBAR(); }
#undef QROW
    pv_tile<0, SK>(o, vb0, pa0, pa1, pa2, pa3, ACT(even ? NT - 2 : NT - 1));
    if (even) { MASKT(pB0, pB1, NT - 1); partialSM(pB0, pB1, m_reg, mnB, alB); __syncthreads(); RESC(alB);
        finishSM(pB0, pB1, alB, l_reg, pa0, pa1, pa2, pa3); SBAR(); pv_tile<1, SK>(o, vb0, pa0, pa1, pa2, pa3, ACT(NT - 1)); }
    SBAR(); SEAM_K0();
    if (hi == 0) li_l[r32] = l_reg; asm volatile("s_waitcnt lgkmcnt(0)" ::: "memory");
    float rli[16];
#pragma unroll
    for (int r = 0; r < 16; ++r) rli[r] = __builtin_amdgcn_rcpf(li_l[crow(r, hi)]);
    TOut* Ow = cur.O + (size_t)(wid * QBLK) * D;
#pragma unroll
    for (int r = 0; r < 16; ++r) { const int orow = crow(r, hi);
#pragma unroll
        for (int d0 = 0; d0 < 4; ++d0) { const float v = o[d0][r] * rli[r];
            if constexpr (same_t<TOut, float>::v) { Ow[(size_t)orow * D + d0 * 32 + r32] = v; }
            else { const float vn = __shfl_xor(v, 1);
                   if ((r32 & 1) == 0) *(unsigned*)(Ow + (size_t)orow * D + d0 * 32 + r32) = cvtpk(v, vn); } } }
    if constexpr (F32) {
#pragma unroll
        for (int d0 = 0; d0 < 8; ++d0) S.qr[d0] = pack8(S.tq[2 * d0], S.tq[2 * d0 + 1]); }
    __syncthreads();
#undef RESC
#undef KBASE
#undef ACT
#undef MASKT
#undef SEAM_K0
#undef HALF_STEP
}
#undef ROW
#undef VMW
#undef VMWN
#undef SLOAD_H
#undef SWRITE_HK
#undef SWRITE_HV
#undef SWRITE_H
#undef SLOAD_F
#undef SWRITE_KF
#undef SWRITE_VF
}
#define LAS __attribute__((address_space(3)))
typedef unsigned short bf16u;
typedef float f32x4 __attribute__((ext_vector_type(4)));
typedef unsigned u32x4 __attribute__((ext_vector_type(4)));
typedef unsigned u32x2 __attribute__((ext_vector_type(2)));
constexpr int MTOK = 8192, DM = 2048, SEQ = 2048, DFF = 5632, NWAVES = 8;
constexpr size_t MiB = (size_t)1 << 20;
constexpr size_t WS_SS = 0, WS_IG = 128 * 1024, WS_FG = 384 * 1024, WS_COS = 640 * 1024, WS_SIN = 1152 * 1024, WS_BAR = 1792 * 1024;
constexpr size_t WS_WIN = 2 * MiB, WS_WOUT = 26 * MiB, WS_WUP0 = 34 * MiB, WS_WDN0 = 78 * MiB, WS_WQKV = 100 * MiB, WS_WO = 124 * MiB, WS_WUP1 = 132 * MiB, WS_WDN1 = 176 * MiB;
constexpr size_t WS_XB = 198 * MiB, WS_R = 230 * MiB, WS_A = 294 * MiB, WS_U = 486 * MiB, WS_SSP = 662 * MiB, WS_END = 666 * MiB;
constexpr size_t WS_PROJ = WS_A, WS_HRAW = WS_A + 96 * MiB, WS_HN = WS_A + 160 * MiB;
constexpr size_t WS_QH = WS_A, WS_OH = WS_A + 96 * MiB, WS_ON = WS_A + 160 * MiB;
constexpr size_t WS_ACT = WS_A;
constexpr int LDS_BYTES = 144 * 1024, LDS_CTL = LDS_BYTES - 64;
constexpr float QSCALE = 0.08838834764831845f;
constexpr float LAMBDA_INIT = 0.35550906759f;

struct Args { const void* in[24]; float* out; unsigned char* ws; float invf[16]; };

__device__ __forceinline__ float wave_sum(float v) {
#pragma unroll
    for (int o = 1; o < 64; o <<= 1) v += __shfl_xor(v, o);
    return v;
}
__device__ __forceinline__ float bf2f(unsigned short b) { return __uint_as_float(((unsigned)b) << 16); }
__device__ __forceinline__ float bflo(unsigned w) { return __uint_as_float(w << 16); }
__device__ __forceinline__ float bfhi(unsigned w) { return __uint_as_float(w & 0xffff0000u); }
typedef float f32x2_t __attribute__((ext_vector_type(2)));
typedef __bf16 bf16x2_t __attribute__((ext_vector_type(2)));
__device__ __forceinline__ unsigned pk2(float lo, float hi) { f32x2_t v = {lo, hi}; bf16x2_t b = __builtin_convertvector(v, bf16x2_t); return __builtin_bit_cast(unsigned, b); }

constexpr int CW_I0 = 3072, CW_I1 = 1024, CW_I2 = 5632, CW_I3 = 2816, CW_I4 = 1024, CW_I5 = 2048, CW_I6 = 1024, CW_I7 = 5632, CW_I8 = 2816;
constexpr int CW_MID = CW_I0, CW_EARLY = CW_I0 + CW_I1 + CW_I2 + CW_I3 + CW_I4 + CW_I5 + CW_I6, CW_ALL = CW_EARLY + CW_I7 + CW_I8;
__device__ __forceinline__ void cw_params(const Args& a, int it, const float*& W, const float*& gain, bf16u*& WT, int& ldw, int& K, int& row_off, int& perm, int& kb, int& nb) {
    unsigned char* ws = a.ws; int r = it, nblk; K = 2048; row_off = 0; perm = 0;
    if (r < CW_I0) { W = (const float*)a.in[3]; ldw = 6160; gain = (const float*)a.in[2]; WT = (bf16u*)(ws + WS_WIN); nblk = 96; }
    else if ((r -= CW_I0) < CW_I1) { W = (const float*)a.in[7]; ldw = 2048; gain = nullptr; WT = (bf16u*)(ws + WS_WOUT); nblk = 32; }
    else if ((r -= CW_I1) < CW_I2) { W = (const float*)a.in[19]; ldw = 11264; gain = (const float*)a.in[18]; WT = (bf16u*)(ws + WS_WUP0); nblk = 176; perm = 1; }
    else if ((r -= CW_I2) < CW_I3) { W = (const float*)a.in[22]; ldw = 2048; gain = nullptr; WT = (bf16u*)(ws + WS_WDN0); nblk = 32; K = 5632; }
    else if ((r -= CW_I3) < CW_I4) { W = (const float*)a.in[11]; ldw = 2048; gain = (const float*)a.in[10]; WT = (bf16u*)(ws + WS_WQKV); nblk = 32; }
    else if ((r -= CW_I4) < CW_I5) { W = (const float*)a.in[9]; ldw = 4096; gain = (const float*)a.in[8]; WT = (bf16u*)(ws + WS_WQKV); nblk = 64; row_off = 2048; }
    else if ((r -= CW_I5) < CW_I6) { W = (const float*)a.in[17]; ldw = 2048; gain = nullptr; WT = (bf16u*)(ws + WS_WO); nblk = 32; }
    else if ((r -= CW_I6) < CW_I7) { W = (const float*)a.in[19] + (size_t)2048 * 11264; ldw = 11264; gain = (const float*)a.in[18] + 2048; WT = (bf16u*)(ws + WS_WUP1); nblk = 176; perm = 1; }
    else { r -= CW_I7; W = (const float*)a.in[22] + (size_t)5632 * 2048; ldw = 2048; gain = nullptr; WT = (bf16u*)(ws + WS_WDN1); nblk = 32; K = 5632; }
    kb = r / nblk; nb = r % nblk;
}
__device__ __forceinline__ void cw_issue(const float* W, int ldw, int kb, int nb, int lane, f32x4 (&t)[16]) {
    const int r = lane >> 4, c4 = lane & 15, k0 = 64 * kb + 16 * r, n0 = 64 * nb + 4 * c4;
    const float* src = W + (size_t)k0 * ldw + n0;
#pragma unroll
    for (int i = 0; i < 16; ++i) t[i] = __builtin_nontemporal_load((const f32x4*)(src + (size_t)i * ldw));
}
__device__ __forceinline__ void cw_finish(const float* gain, bf16u* WT, int K, int row_off, int perm, int kb, int nb, int lane, f32x4 (&t)[16]) {
    const int r = lane >> 4, c4 = lane & 15, k0 = 64 * kb + 16 * r, n0 = 64 * nb + 4 * c4;
    if (gain) {
#pragma unroll
        for (int q = 0; q < 4; ++q) { const f32x4 g = *(const f32x4*)(gain + k0 + 4 * q);
#pragma unroll
            for (int e = 0; e < 4; ++e) t[4 * q + e] = t[4 * q + e] * g[e]; } }
    int d0 = n0; if (perm) { const int bj = n0 >= 5632 ? 1 : 0, rem = n0 - bj * 5632; d0 = 256 * (rem >> 7) + 128 * bj + (rem & 127); }
#pragma unroll
    for (int e = 0; e < 4; ++e) { bf16u* dst = WT + (size_t)(row_off + d0 + e) * K + k0;
        u32x4 o0, o1;
        o0.x = pk2(t[0][e], t[1][e]); o0.y = pk2(t[2][e], t[3][e]); o0.z = pk2(t[4][e], t[5][e]); o0.w = pk2(t[6][e], t[7][e]);
        o1.x = pk2(t[8][e], t[9][e]); o1.y = pk2(t[10][e], t[11][e]); o1.z = pk2(t[12][e], t[13][e]); o1.w = pk2(t[14][e], t[15][e]);
        *(u32x4*)dst = o0; *(u32x4*)(dst + 8) = o1; }
}
__device__ __forceinline__ void convert_weights(const Args& a, int lo, int hi, int vw, int nvw, int lane) {
    for (int it = lo + vw; it < hi; it += 2 * nvw) {
        const bool two = it + nvw < hi; const int itB = two ? it + nvw : it;
        const float *WA, *gA, *WB, *gB; bf16u *TA, *TB; int ldA, KA, roA, pA, kbA, nbA, ldB, KB, roB, pB, kbB, nbB;
        cw_params(a, it, WA, gA, TA, ldA, KA, roA, pA, kbA, nbA); cw_params(a, itB, WB, gB, TB, ldB, KB, roB, pB, kbB, nbB);
        f32x4 tA[16], tB[16];
        cw_issue(WA, ldA, kbA, nbA, lane, tA); cw_issue(WB, ldB, kbB, nbB, lane, tB);
        cw_finish(gA, TA, KA, roA, pA, kbA, nbA, lane, tA);
        if (two) cw_finish(gB, TB, KB, roB, pB, kbB, nbB, lane, tB);
    }
}

__device__ __forceinline__ void p0_prologue(const Args& a, LAS unsigned char* lds) {
    const int tid = ltid(), lane = tid & 63, wave = __builtin_amdgcn_readfirstlane(tid >> 6);
    unsigned char* ws = a.ws;
    const float* x = (const float*)a.in[0]; const int* pos = (const int*)a.in[1];
    const float* a_norm = (const float*)a.in[2]; const float* w_in = (const float*)a.in[3];
    const float* b_ig = (const float*)a.in[4]; const float* b_fg = (const float*)a.in[5];
    const int gw = blockIdx.x * NWAVES + wave, NGW = gridDim.x * NWAVES;
    convert_weights(a, 0, CW_MID, gw, NGW, lane);
    __syncthreads();
    LAS float* G = (LAS float*)lds;
    for (int idx = tid; idx < 2048 * 16; idx += 512) { const int k = idx >> 4, j = idx & 15; G[j * 2048 + k] = a_norm[k] * w_in[(size_t)k * 6160 + 6144 + j]; }
    __syncthreads();
    float* SS0 = (float*)(ws + WS_SSP); float* IG = (float*)(ws + WS_IG); float* FG = (float*)(ws + WS_FG); float* COS = (float*)(ws + WS_COS); float* SIN = (float*)(ws + WS_SIN);
    bf16u* XB = (bf16u*)(ws + WS_XB);
    for (int rg = gw; rg < MTOK / 4; rg += NGW) {
        const int m0 = rg * 4;
        float acc[4][16]; float ssq[4];
#pragma unroll
        for (int r = 0; r < 4; ++r) { ssq[r] = 0.f;
#pragma unroll
            for (int j = 0; j < 16; ++j) acc[r][j] = 0.f; }
#pragma unroll 2
        for (int i = 0; i < 8; ++i) { const int k4 = lane + 64 * i; f32x4 xv[4];
#pragma unroll
            for (int r = 0; r < 4; ++r) { xv[r] = *(const f32x4*)(x + (size_t)(m0 + r) * DM + 4 * k4); ssq[r] += (xv[r][0] * xv[r][0] + xv[r][1] * xv[r][1]) + (xv[r][2] * xv[r][2] + xv[r][3] * xv[r][3]);
                u32x2 w; w.x = pk2(xv[r][0], xv[r][1]); w.y = pk2(xv[r][2], xv[r][3]); *(u32x2*)(XB + (size_t)(m0 + r) * DM + 4 * k4) = w; }
#pragma unroll
            for (int j = 0; j < 16; ++j) { const f32x4 g = *(const LAS f32x4*)(G + j * 2048 + 4 * k4);
#pragma unroll
                for (int r = 0; r < 4; ++r) acc[r][j] += (xv[r][0] * g[0] + xv[r][1] * g[1]) + (xv[r][2] * g[2] + xv[r][3] * g[3]); } }
        float mine[4] = {0.f, 0.f, 0.f, 0.f};
#pragma unroll
        for (int r = 0; r < 4; ++r) { ssq[r] = wave_sum(ssq[r]);
#pragma unroll
            for (int j = 0; j < 16; ++j) { const float v = wave_sum(acc[r][j]); if (lane == j) mine[r] = v; } }
#pragma unroll
        for (int r = 0; r < 4; ++r) { const int m = m0 + r, b = m >> 11, s = m & 2047;
            if (lane < 32) SS0[(size_t)m * 32 + lane] = lane == 0 ? ssq[r] : 0.f;
            if (lane < 16) { const float rs = pg8::rstd_of(ssq[r]); const int j = lane & 7; const float bias = lane < 8 ? b_ig[j] : b_fg[j];
                const float z = 15.0f * tanhf((mine[r] * rs + bias) * (1.0f / 15.0f));
                if (lane < 8) IG[(size_t)(b * 8 + j) * SEQ + s] = z; else FG[(size_t)(b * 8 + j) * SEQ + s] = -log1pf(expf(-z)); }
            else if (lane < 32) { const int i = lane - 16; const float ang = (float)pos[m] * a.invf[i];
                const double rev = (double)ang * 0.15915494309189533577; const float fr = (float)(rev - floor(rev));
                COS[(size_t)m * 16 + i] = __builtin_amdgcn_cosf(fr); SIN[(size_t)m * 16 + i] = __builtin_amdgcn_sinf(fr); } }
    }
}

__device__ __forceinline__ void p2_mlstm_recurrent(const Args& a, LAS unsigned char* lds) {
    const int tid = ltid();
    unsigned char* ws = a.ws;
    const bf16u* PROJ = (const bf16u*)(ws + WS_PROJ); const float* IG = (const float*)(ws + WS_IG); const float* FG = (const float*)(ws + WS_FG); float* HRAW = (float*)(ws + WS_HRAW);
    LAS float* qs = (LAS float*)lds; LAS float* ks = qs + 64 * 128; LAS float* vsl = ks + 64 * 128; LAS float* gi = vsl + 64 * 32; LAS float* gf = gi + 64;
    const int v = tid >> 4, dp = tid & 15;
    for (int unit = blockIdx.x; unit < 256; unit += gridDim.x) {
        const int bh = unit >> 3, vs = unit & 7, b = bh >> 3, h = bh & 7;
        float C[8], n[8]; float mst = 0.f;
#pragma unroll
        for (int e = 0; e < 8; ++e) { C[e] = 0.f; n[e] = 0.f; }
        for (int c = 0; c < 32; ++c) {
            __syncthreads();
            const size_t rowbase = (size_t)(b * SEQ + c * 64);
#pragma unroll
            for (int i = 0; i < 2; ++i) { const int idx = tid + 512 * i, row = idx >> 4, c8 = idx & 15;
                const u32x4 wq = *(const u32x4*)(PROJ + (rowbase + row) * 6144 + h * 128 + c8 * 8);
                const u32x4 wk = *(const u32x4*)(PROJ + (rowbase + row) * 6144 + 1024 + h * 128 + c8 * 8);
                LAS float* qd = qs + row * 128 + c8 * 8; LAS float* kd = ks + row * 128 + c8 * 8;
                qd[0] = bflo(wq.x); qd[1] = bfhi(wq.x); qd[2] = bflo(wq.y); qd[3] = bfhi(wq.y); qd[4] = bflo(wq.z); qd[5] = bfhi(wq.z); qd[6] = bflo(wq.w); qd[7] = bfhi(wq.w);
                kd[0] = bflo(wk.x); kd[1] = bfhi(wk.x); kd[2] = bflo(wk.y); kd[3] = bfhi(wk.y); kd[4] = bflo(wk.z); kd[5] = bfhi(wk.z); kd[6] = bflo(wk.w); kd[7] = bfhi(wk.w); }
            if (tid < 256) { const int row = tid >> 2, c8 = tid & 3;
                const u32x4 wv = *(const u32x4*)(PROJ + (rowbase + row) * 6144 + 2048 + h * 256 + vs * 32 + c8 * 8);
                LAS float* vd = vsl + row * 32 + c8 * 8;
                vd[0] = bflo(wv.x); vd[1] = bfhi(wv.x); vd[2] = bflo(wv.y); vd[3] = bfhi(wv.y); vd[4] = bflo(wv.z); vd[5] = bfhi(wv.z); vd[6] = bflo(wv.w); vd[7] = bfhi(wv.w); }
            else if (tid < 320) gi[tid - 256] = IG[(size_t)bh * SEQ + c * 64 + (tid - 256)];
            else if (tid < 384) gf[tid - 320] = FG[(size_t)bh * SEQ + c * 64 + (tid - 320)];
            __syncthreads();
            for (int t = 0; t < 64; ++t) {
                const float fg = gf[t], ig = gi[t];
                const float mn = fmaxf(fg + mst, ig); const float F = __expf(fg + mst - mn), I = __expf(ig - mn); mst = mn;
                const float vv = vsl[t * 32 + v] * I;
                const f32x4 q0 = *(const LAS f32x4*)(qs + t * 128 + dp * 8), q1 = *(const LAS f32x4*)(qs + t * 128 + dp * 8 + 4);
                const f32x4 k0 = *(const LAS f32x4*)(ks + t * 128 + dp * 8), k1 = *(const LAS f32x4*)(ks + t * 128 + dp * 8 + 4);
                float pn = 0.f, pd = 0.f;
#pragma unroll
                for (int e = 0; e < 4; ++e) { C[e] = F * C[e] + vv * k0[e]; n[e] = F * n[e] + I * k0[e]; pn += C[e] * q0[e]; pd += n[e] * q0[e];
                    C[4 + e] = F * C[4 + e] + vv * k1[e]; n[4 + e] = F * n[4 + e] + I * k1[e]; pn += C[4 + e] * q1[e]; pd += n[4 + e] * q1[e]; }
#pragma unroll
                for (int o = 1; o < 16; o <<= 1) { pn += __shfl_xor(pn, o); pd += __shfl_xor(pd, o); }
                if (dp == 0) HRAW[(rowbase + t) * DM + h * 256 + vs * 32 + v] = pn / fmaxf(fabsf(pd), __expf(-mst));
            }
        }
    }
}

typedef short bf16x8v __attribute__((ext_vector_type(8)));
__device__ __forceinline__ unsigned short f2bf1(float f) { return (unsigned short)(pk2(f, 0.f) & 0xffffu); }
constexpr int ML_DVS = 64, ML_NVT = ML_DVS / 16 + 1, ML_NVR = 16 * ML_NVT, ML_SPH = 256 / ML_DVS, ML_UNITS = 32 * ML_SPH;
__device__ __forceinline__ void p2_mlstm_chunk(const Args& a, LAS unsigned char* lds, int vblock, int vgrid) {
    const int tid = ltid(), lane = tid & 63, wave = __builtin_amdgcn_readfirstlane(tid >> 6), fr = lane & 15, fq = lane >> 4;
    unsigned char* ws = a.ws;
    const bf16u* PROJ = (const bf16u*)(ws + WS_PROJ); const float* IG = (const float*)(ws + WS_IG); const float* FG = (const float*)(ws + WS_FG); bf16u* HRAWB = (bf16u*)(ws + WS_HRAW);
    constexpr int QP = 136, TP = 72;
    LAS bf16u* Qs = (LAS bf16u*)lds;
    LAS bf16u* Ks = Qs + 64 * QP;
    LAS bf16u* KT = Ks + 64 * QP;
    LAS bf16u* VT = KT + 128 * TP;
    LAS bf16u* Ps = VT + ML_NVR * TP;
    LAS bf16u* Cb = Ps + 64 * TP;
    LAS float* AVs = (LAS float*)(Cb + 2 * ML_NVR * QP);
    LAS float* CMs = AVs + 32 * 64;
    LAS float* BSs = CMs + 32 * 64;
    LAS float* MCs = BSs + 32 * 64;
    for (int unit = vblock; unit < ML_UNITS; unit += vgrid) {
        const int bh = unit / ML_SPH, vs = unit % ML_SPH, b = bh >> 3, h = bh & 7;
        __syncthreads();
        for (int i = tid; i < 16 * 64; i += 512) { const int row = ML_DVS + (i >> 6), s = i & 63; VT[row * TP + s] = (row == ML_DVS) ? (bf16u)0x3F80u : (bf16u)0u; }
        for (int i = tid; i < ML_NVR * QP; i += 512) Cb[i] = (bf16u)0u;
#pragma unroll
        for (int k = 0; k < 4; ++k) { const int c = wave + 8 * k;
            float bsum = FG[(size_t)bh * SEQ + c * 64 + lane]; const float ig = IG[(size_t)bh * SEQ + c * 64 + lane];
#pragma unroll
            for (int d = 1; d < 64; d <<= 1) { const float t = __shfl_up(bsum, d); if (lane >= d) bsum += t; }
            const float av = ig - bsum; float cm = av;
#pragma unroll
            for (int d = 1; d < 64; d <<= 1) { const float t = __shfl_up(cm, d); if (lane >= d) cm = fmaxf(cm, t); }
            AVs[c * 64 + lane] = av; CMs[c * 64 + lane] = cm; BSs[c * 64 + lane] = bsum; }
        f32x4 cacc[ML_NVT][2];
#pragma unroll
        for (int v = 0; v < ML_NVT; ++v) { cacc[v][0] = (f32x4){0.f, 0.f, 0.f, 0.f}; cacc[v][1] = (f32x4){0.f, 0.f, 0.f, 0.f}; }
        u32x4 pq[2], pk[2], pv;
        pv = (u32x4){0u, 0u, 0u, 0u};
#define ML_LOAD(c_) do { const size_t rb_ = (size_t)(b * SEQ + (c_) * 64); \
            _Pragma("unroll") for (int i_ = 0; i_ < 2; ++i_) { const int idx_ = tid + 512 * i_, row_ = idx_ >> 4, c8_ = idx_ & 15, rowk_ = idx_ & 63, c8k_ = idx_ >> 6; \
                pq[i_] = *(const u32x4*)(PROJ + (rb_ + row_) * 6144 + h * 128 + c8_ * 8); pk[i_] = *(const u32x4*)(PROJ + (rb_ + rowk_) * 6144 + 1024 + h * 128 + c8k_ * 8); } \
            if (tid < 8 * ML_DVS) pv = *(const u32x4*)(PROJ + (rb_ + (tid & 63)) * 6144 + 2048 + h * 256 + vs * ML_DVS + (tid >> 6) * 8); } while (0)
        ML_LOAD(0);
        __syncthreads();
        if (wave == 0) {
            const float Bc = BSs[(lane & 31) * 64 + 63], Ac = CMs[(lane & 31) * 64 + 63]; float m = 0.f, mine = 0.f;
#pragma unroll
            for (int c = 0; c < 32; ++c) { if (lane == c) mine = m;
                m = __uint_as_float(__builtin_amdgcn_readlane(__float_as_uint(Bc), c)) + fmaxf(m, __uint_as_float(__builtin_amdgcn_readlane(__float_as_uint(Ac), c))); }
            if (lane < 32) MCs[lane] = mine; }
        for (int c = 0; c < 32; ++c) {
            const size_t rowbase = (size_t)(b * SEQ + c * 64);
#pragma unroll
            for (int i = 0; i < 2; ++i) { const int idx = tid + 512 * i, row = idx >> 4, c8 = idx & 15, rowk = idx & 63, c8k = idx >> 6;
                *(LAS u32x4*)(Qs + row * QP + c8 * 8) = pq[i]; *(LAS u32x4*)(Ks + rowk * QP + c8k * 8) = pk[i];
#pragma unroll
                for (int q = 0; q < 4; ++q) { KT[(c8k * 8 + 2 * q) * TP + rowk] = (bf16u)(pk[i][q] & 0xffffu); KT[(c8k * 8 + 2 * q + 1) * TP + rowk] = (bf16u)(pk[i][q] >> 16); } }
            if (tid < 8 * ML_DVS) { const int row = tid & 63, c8 = tid >> 6;
#pragma unroll
                for (int q = 0; q < 4; ++q) { VT[(c8 * 8 + 2 * q) * TP + row] = (bf16u)(pv[q] & 0xffffu); VT[(c8 * 8 + 2 * q + 1) * TP + row] = (bf16u)(pv[q] >> 16); } }
            if (c + 1 < 32) ML_LOAD(c + 1);
            __syncthreads();
            const float mc = MCs[c], M63 = fmaxf(mc, CMs[c * 64 + 63]);
            { const int i = wave >> 1; const f32x4 cm4 = *(const LAS f32x4*)(CMs + c * 64 + 16 * i + 4 * fq);
#pragma unroll
              for (int j2 = 0; j2 < 2; ++j2) { const int j = (wave & 1) * 2 + j2;
                if (j <= i) { f32x4 acc = (f32x4){0.f, 0.f, 0.f, 0.f};
#pragma unroll
                    for (int ks = 0; ks < 4; ++ks) { const bf16x8v A = *(const LAS bf16x8v*)(Qs + (16 * i + fr) * QP + 32 * ks + 8 * fq), B = *(const LAS bf16x8v*)(Ks + (16 * j + fr) * QP + 32 * ks + 8 * fq);
                        acc = __builtin_amdgcn_mfma_f32_16x16x32_bf16(A, B, acc, 0, 0, 0); }
                    const int s = 16 * j + fr; const float a_s = AVs[c * 64 + s];
#pragma unroll
                    for (int e = 0; e < 4; ++e) { const int t = 16 * i + 4 * fq + e; const float M_t = fmaxf(mc, cm4[e]);
                        const float p = (s <= t) ? acc[e] * __expf(a_s - M_t) : 0.f; Ps[t * TP + s] = f2bf1(p); } }
                else {
#pragma unroll
                    for (int e = 0; e < 4; ++e) Ps[(16 * i + 4 * fq + e) * TP + 16 * j + fr] = (bf16u)0u; } } }
            __syncthreads();
            if (wave < 4) {
                const int i = wave; const LAS bf16u* cb = Cb + (c & 1) * ML_NVR * QP;
                f32x4 a1[ML_NVT], a2[ML_NVT];
#pragma unroll
                for (int v = 0; v < ML_NVT; ++v) { a1[v] = (f32x4){0.f, 0.f, 0.f, 0.f}; a2[v] = (f32x4){0.f, 0.f, 0.f, 0.f}; }
#pragma unroll
                for (int ks = 0; ks < 4; ++ks) { const bf16x8v A = *(const LAS bf16x8v*)(Qs + (16 * i + fr) * QP + 32 * ks + 8 * fq);
#pragma unroll
                    for (int v = 0; v < ML_NVT; ++v) { const bf16x8v B = *(const LAS bf16x8v*)(cb + (16 * v + fr) * QP + 32 * ks + 8 * fq); a1[v] = __builtin_amdgcn_mfma_f32_16x16x32_bf16(A, B, a1[v], 0, 0, 0); } }
#pragma unroll
                for (int ks = 0; ks < 2; ++ks) { const bf16x8v A = *(const LAS bf16x8v*)(Ps + (16 * i + fr) * TP + 32 * ks + 8 * fq);
#pragma unroll
                    for (int v = 0; v < ML_NVT; ++v) { const bf16x8v B = *(const LAS bf16x8v*)(VT + (16 * v + fr) * TP + 32 * ks + 8 * fq); a2[v] = __builtin_amdgcn_mfma_f32_16x16x32_bf16(A, B, a2[v], 0, 0, 0); } }
                const f32x4 cm4 = *(const LAS f32x4*)(CMs + c * 64 + 16 * i + 4 * fq), bs4 = *(const LAS f32x4*)(BSs + c * 64 + 16 * i + 4 * fq);
#pragma unroll
                for (int e = 0; e < 4; ++e) { const int t = 16 * i + 4 * fq + e; const float M_t = fmaxf(mc, cm4[e]); const float wi = __expf(mc - M_t), ei = __expf(-bs4[e] - M_t);
                    float den = wi * a1[ML_NVT - 1][e] + a2[ML_NVT - 1][e]; den = __shfl(den, lane & 48);
                    const float rdn = __builtin_amdgcn_rcpf(fmaxf(fabsf(den), ei)); bf16u* hrow = HRAWB + (rowbase + t) * DM + h * 256 + vs * ML_DVS + fr;
#pragma unroll
                    for (int v = 0; v < ML_NVT - 1; ++v) hrow[16 * v] = f2bf1((wi * a1[v][e] + a2[v][e]) * rdn); }
            } else {
                const int w4 = wave - 4; LAS bf16u* nb = Cb + ((c + 1) & 1) * ML_NVR * QP; const float decay = __expf(mc - M63);
#pragma unroll
                for (int v = 0; v < ML_NVT; ++v) { cacc[v][0] = cacc[v][0] * decay; cacc[v][1] = cacc[v][1] * decay; }
#pragma unroll
                for (int ks = 0; ks < 2; ++ks) { const f32x4 av0 = *(const LAS f32x4*)(AVs + c * 64 + 32 * ks + 8 * fq), av1 = *(const LAS f32x4*)(AVs + c * 64 + 32 * ks + 8 * fq + 4); float wgf[8];
#pragma unroll
                    for (int e = 0; e < 4; ++e) { wgf[e] = __expf(av0[e] - M63); wgf[4 + e] = __expf(av1[e] - M63); }
                    const bf16x8v B0 = *(const LAS bf16x8v*)(KT + (16 * (2 * w4) + fr) * TP + 32 * ks + 8 * fq), B1 = *(const LAS bf16x8v*)(KT + (16 * (2 * w4 + 1) + fr) * TP + 32 * ks + 8 * fq);
#pragma unroll
                    for (int v = 0; v < ML_NVT; ++v) { const u32x4 raw = *(const LAS u32x4*)(VT + (16 * v + fr) * TP + 32 * ks + 8 * fq); u32x4 sc;
#pragma unroll
                        for (int q = 0; q < 4; ++q) sc[q] = pk2(bflo(raw[q]) * wgf[2 * q], bfhi(raw[q]) * wgf[2 * q + 1]);
                        const bf16x8v A = __builtin_bit_cast(bf16x8v, sc);
                        cacc[v][0] = __builtin_amdgcn_mfma_f32_16x16x32_bf16(A, B0, cacc[v][0], 0, 0, 0); cacc[v][1] = __builtin_amdgcn_mfma_f32_16x16x32_bf16(A, B1, cacc[v][1], 0, 0, 0); } }
#pragma unroll
                for (int v = 0; v < ML_NVT; ++v)
#pragma unroll
                    for (int dd = 0; dd < 2; ++dd)
#pragma unroll
                        for (int e = 0; e < 4; ++e) nb[(16 * v + 4 * fq + e) * QP + 16 * (2 * w4 + dd) + fr] = f2bf1(cacc[v][dd][e]);
            }
            __syncthreads();
        }
#undef ML_LOAD
    }
}

__device__ __forceinline__ void p3_hnorm(const Args& a) {
    const int tid = ltid(), lane = tid & 63, wave = __builtin_amdgcn_readfirstlane(tid >> 6);
    unsigned char* ws = a.ws;
    const bf16u* HRAW = (const bf16u*)(ws + WS_HRAW); const bf16u* PROJ = (const bf16u*)(ws + WS_PROJ); bf16u* HN = (bf16u*)(ws + WS_HN); const float* w_hn = (const float*)a.in[6];
    const int gw = blockIdx.x * NWAVES + wave, NGW = gridDim.x * NWAVES;
    for (int it = gw; it < MTOK * 8; it += NGW) { const int m = it >> 3, h = it & 7; const size_t off = (size_t)m * DM + h * 256 + 4 * lane;
        const u32x2 hw = __builtin_nontemporal_load((const u32x2*)(HRAW + off)); const f32x4 hv = {bflo(hw.x), bfhi(hw.x), bflo(hw.y), bfhi(hw.y)};
        const float ss = wave_sum((hv[0] * hv[0] + hv[1] * hv[1]) + (hv[2] * hv[2] + hv[3] * hv[3]));
        const float rs = rsqrtf(ss * (1.0f / 256.0f) + 1e-6f);
        const u32x2 og = __builtin_nontemporal_load((const u32x2*)(PROJ + (size_t)m * 6144 + 4096 + h * 256 + 4 * lane));
        const f32x4 w = *(const f32x4*)(w_hn + h * 256 + 4 * lane);
        const float o0 = bflo(og.x), o1 = bfhi(og.x), o2 = bflo(og.y), o3 = bfhi(og.y);
        const float r0 = hv[0] * rs * w[0] / (1.f + __expf(-o0)), r1 = hv[1] * rs * w[1] / (1.f + __expf(-o1));
        const float r2 = hv[2] * rs * w[2] / (1.f + __expf(-o2)), r3 = hv[3] * rs * w[3] / (1.f + __expf(-o3));
        u32x2 o; o.x = pk2(r0, r1); o.y = pk2(r2, r3); *(u32x2*)(HN + off) = o; }
}

__device__ __forceinline__ void p_conv(const Args& a, int layer) {
    const int tid = ltid();
    unsigned char* ws = a.ws;
    const bf16u* U = (const bf16u*)(ws + WS_U); bf16u* ACT = (bf16u*)(ws + WS_ACT);
    const float* cw = (const float*)a.in[20] + (size_t)layer * 3 * 11264; const float* cb = (const float*)a.in[21] + (size_t)layer * 11264;
    constexpr int NCG = DFF / 8, RUN = 16, NITEM = NCG * (MTOK / RUN);
    for (int idx = blockIdx.x * 512 + tid; idx < NITEM; idx += gridDim.x * 512) {
        const int cgp = idx % NCG, rr = idx / NCG, f0 = cgp * 8, m0 = rr * RUN;
        float wg[3][8], wv[3][8], bg[8], bv[8], p2g[8], p1g[8], p2v[8], p1v[8];
#pragma unroll
        for (int j = 0; j < 3; ++j) {
#pragma unroll
            for (int q = 0; q < 2; ++q) { const f32x4 g4 = *(const f32x4*)(cw + j * 11264 + f0 + 4 * q), v4 = *(const f32x4*)(cw + j * 11264 + DFF + f0 + 4 * q);
#pragma unroll
                for (int e = 0; e < 4; ++e) { wg[j][4 * q + e] = g4[e]; wv[j][4 * q + e] = v4[e]; } } }
#pragma unroll
        for (int q = 0; q < 2; ++q) { const f32x4 g4 = *(const f32x4*)(cb + f0 + 4 * q), v4 = *(const f32x4*)(cb + DFF + f0 + 4 * q);
#pragma unroll
            for (int e = 0; e < 4; ++e) { bg[4 * q + e] = g4[e]; bv[4 * q + e] = v4[e]; } }
#pragma unroll
        for (int e = 0; e < 8; ++e) { p2g[e] = 0.f; p1g[e] = 0.f; p2v[e] = 0.f; p1v[e] = 0.f; }
        if ((m0 & (SEQ - 1)) != 0) {
            const u32x4 a2 = *(const u32x4*)(U + (size_t)(m0 - 2) * 11264 + f0), a1 = *(const u32x4*)(U + (size_t)(m0 - 1) * 11264 + f0);
            const u32x4 b2 = *(const u32x4*)(U + (size_t)(m0 - 2) * 11264 + DFF + f0), b1 = *(const u32x4*)(U + (size_t)(m0 - 1) * 11264 + DFF + f0);
#pragma unroll
            for (int q = 0; q < 4; ++q) { p2g[2 * q] = bflo(a2[q]); p2g[2 * q + 1] = bfhi(a2[q]); p1g[2 * q] = bflo(a1[q]); p1g[2 * q + 1] = bfhi(a1[q]);
                p2v[2 * q] = bflo(b2[q]); p2v[2 * q + 1] = bfhi(b2[q]); p1v[2 * q] = bflo(b1[q]); p1v[2 * q + 1] = bfhi(b1[q]); }
        }
#pragma unroll 4
        for (int r = 0; r < RUN; ++r) {
            const u32x4 ug = *(const u32x4*)(U + (size_t)(m0 + r) * 11264 + f0), uv = *(const u32x4*)(U + (size_t)(m0 + r) * 11264 + DFF + f0);
            float cg_[8], cv_[8], o[8];
#pragma unroll
            for (int q = 0; q < 4; ++q) { cg_[2 * q] = bflo(ug[q]); cg_[2 * q + 1] = bfhi(ug[q]); cv_[2 * q] = bflo(uv[q]); cv_[2 * q + 1] = bfhi(uv[q]); }
#pragma unroll
            for (int e = 0; e < 8; ++e) { const float g = bg[e] + wg[0][e] * p2g[e] + wg[1][e] * p1g[e] + wg[2][e] * cg_[e];
                const float vv = bv[e] + wv[0][e] * p2v[e] + wv[1][e] * p1v[e] + wv[2][e] * cv_[e];
                o[e] = g / (1.f + __expf(-g)) * vv; p2g[e] = p1g[e]; p1g[e] = cg_[e]; p2v[e] = p1v[e]; p1v[e] = cv_[e]; }
            u32x4 w; w.x = pk2(o[0], o[1]); w.y = pk2(o[2], o[3]); w.z = pk2(o[4], o[5]); w.w = pk2(o[6], o[7]);
            *(u32x4*)(ACT + (size_t)(m0 + r) * DFF + f0) = w;
        }
    }
}


__device__ __forceinline__ void p_convfix(const Args& a, int layer) {
    const int tid = ltid();
    unsigned char* ws = a.ws;
    const bf16u* US = (const bf16u*)(ws + WS_U); bf16u* ACT = (bf16u*)(ws + WS_ACT);
    const float* cw = (const float*)a.in[20] + (size_t)layer * 3 * 11264; const float* cb = (const float*)a.in[21] + (size_t)layer * 11264;
    constexpr int NCG = DFF / 8, NITEM = NCG * (MTOK / 64);
    for (int idx = blockIdx.x * 512 + tid; idx < NITEM; idx += gridDim.x * 512) {
        const int cgp = idx % NCG, k = idx / NCG, f0 = cgp * 8;
        float x[4][2][8];
#pragma unroll
        for (int q = 0; q < 4; ++q) { const bool zero = (q < 2) && ((k & 31) == 0); const int kk = q < 2 ? k - 1 : k;
#pragma unroll
            for (int gv = 0; gv < 2; ++gv) { u32x4 w = (u32x4){0u, 0u, 0u, 0u};
                if (!zero) w = *(const u32x4*)(US + (size_t)(kk * 4 + q) * 11264 + gv * DFF + f0);
#pragma unroll
                for (int e = 0; e < 4; ++e) { x[q][gv][2 * e] = bflo(w[e]); x[q][gv][2 * e + 1] = bfhi(w[e]); } } }
        float o0[8], o1[8];
#pragma unroll
        for (int h = 0; h < 2; ++h) { const f32x4 wg0 = *(const f32x4*)(cw + f0 + 4 * h), wg1 = *(const f32x4*)(cw + 11264 + f0 + 4 * h), wg2 = *(const f32x4*)(cw + 22528 + f0 + 4 * h), bg = *(const f32x4*)(cb + f0 + 4 * h);
            const f32x4 wv0 = *(const f32x4*)(cw + DFF + f0 + 4 * h), wv1 = *(const f32x4*)(cw + 11264 + DFF + f0 + 4 * h), wv2 = *(const f32x4*)(cw + 22528 + DFF + f0 + 4 * h), bv = *(const f32x4*)(cb + DFF + f0 + 4 * h);
#pragma unroll
            for (int j = 0; j < 4; ++j) { const int e = 4 * h + j;
                const float ga = bg[j] + wg0[j] * x[0][0][e] + wg1[j] * x[1][0][e] + wg2[j] * x[2][0][e], va = bv[j] + wv0[j] * x[0][1][e] + wv1[j] * x[1][1][e] + wv2[j] * x[2][1][e];
                const float gb = bg[j] + wg0[j] * x[1][0][e] + wg1[j] * x[2][0][e] + wg2[j] * x[3][0][e], vb = bv[j] + wv0[j] * x[1][1][e] + wv1[j] * x[2][1][e] + wv2[j] * x[3][1][e];
                o0[e] = ga / (1.f + __expf(-ga)) * va; o1[e] = gb / (1.f + __expf(-gb)) * vb; } }
        u32x4 w; w.x = pk2(o0[0], o0[1]); w.y = pk2(o0[2], o0[3]); w.z = pk2(o0[4], o0[5]); w.w = pk2(o0[6], o0[7]);
        *(u32x4*)(ACT + (size_t)(64 * k) * DFF + f0) = w;
        w.x = pk2(o1[0], o1[1]); w.y = pk2(o1[2], o1[3]); w.z = pk2(o1[4], o1[5]); w.w = pk2(o1[6], o1[7]);
        *(u32x4*)(ACT + (size_t)(64 * k + 1) * DFF + f0) = w;
    }
}

__device__ __forceinline__ attn::BlockRef<attn::bf16, attn::bf16> att_ref(unsigned char* ws, int L, int pass) {
    const int xcd = L & 7, k = L >> 3, bh = xcd * 4 + (k >> 4), within = k & 15, virt = within >> 2, x = within & 3, c = virt >> 1, half = virt & 1, b = bh >> 3, h = bh & 7;
    const int qb = pass ? 7 - x : x;
    attn::bf16* QH = (attn::bf16*)(ws + WS_QH); attn::bf16* KH = QH + (size_t)MTOK * DM; attn::bf16* VH = KH + (size_t)MTOK * DM; attn::bf16* OH = (attn::bf16*)(ws + WS_OH);
    attn::BlockRef<attn::bf16, attn::bf16> r;
    r.Q = QH + ((size_t)(b * 16 + 2 * h + c) * SEQ + (size_t)qb * 256) * 128;
    r.K = KH + (size_t)(b * 16 + 2 * h + c) * SEQ * 128;
    r.V = VH + (size_t)(b * 16 + 2 * h + half) * SEQ * 128;
    r.O = OH + ((size_t)(b * 32 + (2 * h + c) * 2 + half) * SEQ + (size_t)qb * 256) * 128;
    r.P0 = qb * 256;
    return r;
}
__device__ __forceinline__ void p_attention(const Args& a, char* lds) {
    typedef attn::BlockRef<attn::bf16, attn::bf16> BR;
    const int total = 512, stride = gridDim.x; int L = blockIdx.x; if (L >= total) return;
    int pass = 0; BR cur = att_ref(a.ws, L, 0);
    attn::Seam<attn::bf16> S;
    attn::causal_swa_prime<attn::bf16, attn::bf16>(cur, SEQ, lds, S);
    for (;;) {
        const bool more_pass = pass == 0, more_item = L + stride < total, last = !more_pass && !more_item;
        int passn = pass + 1, Ln = L;
        if (!more_pass) { passn = 0; Ln = more_item ? L + stride : L; }
        const BR nxt = last ? cur : att_ref(a.ws, Ln, passn);
        attn::causal_swa_block<attn::bf16, attn::bf16>(cur, nxt, SEQ, SEQ, lds, S);
        if (last) break;
        cur = nxt; pass = passn; L = Ln;
    }
}

__device__ __forceinline__ void p_diffnorm(const Args& a) {
    const int tid = ltid(), lane = tid & 63, wave = __builtin_amdgcn_readfirstlane(tid >> 6);
    unsigned char* ws = a.ws;
    const bf16u* OH = (const bf16u*)(ws + WS_OH); bf16u* ON = (bf16u*)(ws + WS_ON); const float* subln = (const float*)a.in[16];
    const float* lq1 = (const float*)a.in[12]; const float* lk1 = (const float*)a.in[13]; const float* lq2 = (const float*)a.in[14]; const float* lk2 = (const float*)a.in[15];
    const float d1 = wave_sum(lq1[lane] * lk1[lane] + lq1[lane + 64] * lk1[lane + 64]), d2 = wave_sum(lq2[lane] * lk2[lane] + lq2[lane + 64] * lk2[lane + 64]);
    const float lam = expf(d1) - expf(d2) + LAMBDA_INIT;
    const int gw = blockIdx.x * NWAVES + wave, NGW = gridDim.x * NWAVES;
    const int vh = lane >> 5, d = (lane & 31) * 4;
    const f32x4 g = *(const f32x4*)(subln + vh * 128 + d);
    for (int it = gw; it < MTOK * 8; it += NGW) { const int m = it >> 3, h = it & 7, b = m >> 11, s = m & 2047;
        const u32x2 w0 = __builtin_nontemporal_load((const u32x2*)(OH + ((size_t)(b * 32 + (2 * h + 0) * 2 + vh) * SEQ + s) * 128 + d));
        const u32x2 w1 = __builtin_nontemporal_load((const u32x2*)(OH + ((size_t)(b * 32 + (2 * h + 1) * 2 + vh) * SEQ + s) * 128 + d));
        const float e0 = bflo(w0.x) - lam * bflo(w1.x), e1 = bfhi(w0.x) - lam * bfhi(w1.x), e2 = bflo(w0.y) - lam * bflo(w1.y), e3 = bfhi(w0.y) - lam * bfhi(w1.y);
        const float ss = wave_sum((e0 * e0 + e1 * e1) + (e2 * e2 + e3 * e3));
        const float rs = rsqrtf(ss * (1.0f / 256.0f) + 1e-6f) * (1.0f - LAMBDA_INIT);
        u32x2 o; o.x = pk2(e0 * rs * g[0], e1 * rs * g[1]); o.y = pk2(e2 * rs * g[2], e3 * rs * g[3]);
        *(u32x2*)(ON + (size_t)m * DM + h * 256 + vh * 128 + d) = o; }
}

__device__ __forceinline__ void p_final(const Args& a) {
    const int tid = ltid(), lane = tid & 63, wave = __builtin_amdgcn_readfirstlane(tid >> 6);
    const bf16u* XBf = (const bf16u*)(a.ws + WS_XB); const float* fn = (const float*)a.in[23];
    const int gw = blockIdx.x * NWAVES + wave, NGW = gridDim.x * NWAVES;
    for (int m = gw; m < MTOK; m += NGW) { const u32x4* xr = (const u32x4*)(XBf + (size_t)m * DM) + lane; f32x4 v[8]; float s = 0.f;
#pragma unroll
        for (int j = 0; j < 4; ++j) { const u32x4 w = __builtin_nontemporal_load(xr + 64 * j);
            v[2 * j] = (f32x4){bflo(w.x), bfhi(w.x), bflo(w.y), bfhi(w.y)}; v[2 * j + 1] = (f32x4){bflo(w.z), bfhi(w.z), bflo(w.w), bfhi(w.w)};
            s += (v[2 * j][0] * v[2 * j][0] + v[2 * j][1] * v[2 * j][1]) + (v[2 * j][2] * v[2 * j][2] + v[2 * j][3] * v[2 * j][3]);
            s += (v[2 * j + 1][0] * v[2 * j + 1][0] + v[2 * j + 1][1] * v[2 * j + 1][1]) + (v[2 * j + 1][2] * v[2 * j + 1][2] + v[2 * j + 1][3] * v[2 * j + 1][3]); }
        const float rs = pg8::rstd_of(wave_sum(s)); float* orow = a.out + (size_t)m * DM;
#pragma unroll
        for (int j = 0; j < 4; ++j) { const int c = 8 * (lane + 64 * j); const f32x4 g0 = *(const f32x4*)(fn + c), g1 = *(const f32x4*)(fn + c + 4);
            __builtin_nontemporal_store(v[2 * j] * rs * g0, (f32x4*)(orow + c)); __builtin_nontemporal_store(v[2 * j + 1] * rs * g1, (f32x4*)(orow + c + 4)); } }
}

template <class Epi> __device__ __forceinline__ void run_gemm(LAS unsigned char* lds, const bf16u* A, const bf16u* Bt, int N, int K, const Epi& E) {
    pg8::Gemm g{A, Bt, MTOK, N, K}; pg8::StaticOrder S; S.init(MTOK, N, (int)gridDim.x, (int)blockIdx.x);
    pg8::gemm_phase<Epi, pg8::StaticOrder, true, true>((PG8_LAS unsigned char*)lds, g, S, E);
}

#define XB_TMO      128
#define XB_XCNT(j)  (256  + 64 * (j))
#define XB_XSUB(j)  (1280 + 64 * (j))
#define XB_XGEN(j)  (2304 + 64 * (j))
#define XB_TOP      3328
#define XB_TOPGEN   3392
#define XCD_BAR_WORDS 3456
#define XB_SPIN_CAP (1u << 18)

__device__ __forceinline__ unsigned xb_ld(unsigned* p)              { return __hip_atomic_load(p, __ATOMIC_RELAXED, __HIP_MEMORY_SCOPE_AGENT); }
__device__ __forceinline__ unsigned xb_add(unsigned* p, unsigned v) { return __hip_atomic_fetch_add(p, v, __ATOMIC_RELAXED, __HIP_MEMORY_SCOPE_AGENT); }
__device__ __forceinline__ unsigned xb_xcc_id() { return (unsigned)__builtin_amdgcn_s_getreg((3 << 11) | 20) & 0xFu; }
#define XB_SPIN(cond, bar) do { unsigned _sp = 0; while (cond) { __builtin_amdgcn_s_sleep(1); \
    if ((++_sp & 255u) == 0u) { if (xb_ld(&(bar)[XB_TMO])) break; if (_sp > XB_SPIN_CAP) { atomicAdd(&(bar)[XB_TMO], 1u); break; } } } } while (0)

struct XcdBarrier {
    unsigned* bar; unsigned x;
    volatile LAS unsigned* st;
};

__device__ __forceinline__ XcdBarrier xcd_barrier_post(unsigned* bar, volatile LAS unsigned* st) {
    XcdBarrier b; b.bar = bar; b.x = xb_xcc_id(); b.st = st;
    if (threadIdx.x == 0) (void)xb_add(&bar[XB_XCNT(b.x)], 1u);
    return b;
}
__device__ __forceinline__ void xcd_barrier_complete(unsigned* bar, unsigned x, unsigned& nloc, unsigned& nx) {
    const unsigned G = gridDim.x * gridDim.y * gridDim.z;
    unsigned sum, cnt, mine, sp = 0u;
    for (;;) {
        sum = 0u; cnt = 0u; mine = 0u;
#pragma unroll
        for (unsigned j = 0; j < 16; ++j) { const unsigned c = xb_ld(&bar[XB_XCNT(j)]); sum += c; cnt += (c > 0u) ? 1u : 0u; mine = (j == x) ? c : mine; }
        if (sum == G) break;
        __builtin_amdgcn_s_sleep(1);
        if ((++sp & 255u) == 0u) { if (xb_ld(&bar[XB_TMO])) break; if (sp > XB_SPIN_CAP) { atomicAdd(&bar[XB_TMO], 1u); break; } }
    }
    nloc = mine > 0u ? mine : 1u; nx = cnt > 0u ? cnt : 1u;
}

__device__ __forceinline__ void xcd_barrier(const XcdBarrier& b) {
    asm volatile("s_waitcnt vmcnt(0)" ::: "memory");
    __syncthreads();
    if (threadIdx.x == 0) {
        unsigned* bar = b.bar;
        __builtin_amdgcn_s_waitcnt(0);
        unsigned nloc = b.st[0], nx = b.st[1];
        if (nloc == 0u) { xcd_barrier_complete(bar, b.x, nloc, nx); b.st[0] = nloc; b.st[1] = nx; }
        const unsigned old = xb_add(&bar[XB_XSUB(b.x)], 1u);
        const unsigned gen = old / nloc;
        if (old + 1u == (gen + 1u) * nloc) {
            __builtin_amdgcn_fence(__ATOMIC_RELEASE, "agent");
            asm volatile("s_waitcnt vmcnt(0)" ::: "memory");
            const unsigned og = xb_add(&bar[XB_TOP], 1u);
            const unsigned tg = og / nx;
            if (og + 1u == (tg + 1u) * nx) xb_add(&bar[XB_TOPGEN], 1u);
            else XB_SPIN(xb_ld(&bar[XB_TOPGEN]) == tg, bar);
            __builtin_amdgcn_fence(__ATOMIC_ACQUIRE, "agent");
            xb_add(&bar[XB_XGEN(b.x)], 1u);
            asm volatile("s_waitcnt vmcnt(0)" ::: "memory");
        } else {
            XB_SPIN(xb_ld(&bar[XB_XGEN(b.x)]) == gen, bar);
            __builtin_amdgcn_fence(__ATOMIC_ACQUIRE, "agent");
            asm volatile("s_waitcnt vmcnt(0)" ::: "memory");
        }
    }
    __syncthreads();
}

__global__ void __launch_bounds__(512, 2) fwd_megakernel(Args a) {
    extern __shared__ __attribute__((aligned(16))) unsigned char lds[];
    cg::grid_group grid = cg::this_grid();
    LAS unsigned char* L = (LAS unsigned char*)lds;
    unsigned char* ws = a.ws;
    float* SS = (float*)(ws + WS_SSP); constexpr int SSN = MTOK * 32; bf16u* XB = (bf16u*)(ws + WS_XB); float* R = (float*)(ws + WS_R);
    if (threadIdx.x < 2) ((volatile LAS unsigned*)(L + LDS_CTL))[threadIdx.x] = 0u;
    __syncthreads();
    XcdBarrier xbar = xcd_barrier_post((unsigned*)(ws + WS_BAR), (volatile LAS unsigned*)(L + LDS_CTL));
#define GSYNC() xcd_barrier(xbar)
#define GSYNC0() xcd_barrier(xbar)
    if (__builtin_expect(a.out == nullptr, 0)) { asm volatile("s_waitcnt vmcnt(0) lgkmcnt(0)" ::: "memory"); __syncthreads(); grid.sync(); __builtin_amdgcn_fence(__ATOMIC_ACQUIRE, "agent"); asm volatile("s_waitcnt vmcnt(0)" ::: "memory"); __syncthreads(); }
#ifndef NO_P0
    p0_prologue(a, L);
#ifdef DUP_P0
    __syncthreads(); p0_prologue(a, L);
#endif
#endif
    GSYNC0();
    { pg8::EpiScaleBf16 E{(bf16u*)(ws + WS_PROJ), 6144, SS, 4, QSCALE}; run_gemm(L, XB, (const bf16u*)(ws + WS_WIN), 6144, 2048, E); }
#ifdef DUP_INPROJ
    GSYNC();
    { pg8::EpiScaleBf16 E{(bf16u*)(ws + WS_PROJ), 6144, SS, 4, QSCALE}; run_gemm(L, XB, (const bf16u*)(ws + WS_WIN), 6144, 2048, E); }
#endif
    GSYNC();
#ifndef NO_ML
    if ((int)gridDim.x == 256) { if ((int)blockIdx.x < 128) p2_mlstm_chunk(a, L, ((int)blockIdx.x & 7) * 16 + ((int)blockIdx.x >> 3), 128);
        else { const int t_ = ltid(); convert_weights(a, CW_MID, CW_EARLY, ((int)blockIdx.x - 128) * NWAVES + (t_ >> 6), 128 * NWAVES, t_ & 63); convert_weights(a, CW_EARLY + CW_I7, CW_ALL, ((int)blockIdx.x - 128) * NWAVES + (t_ >> 6), 128 * NWAVES, t_ & 63); } }
    else { p2_mlstm_chunk(a, L, (int)blockIdx.x, (int)gridDim.x); const int t_ = ltid(); convert_weights(a, CW_MID, CW_EARLY, (int)blockIdx.x * NWAVES + (t_ >> 6), (int)gridDim.x * NWAVES, t_ & 63); }
#ifdef DUP_ML
    __syncthreads(); p2_mlstm_chunk(a, L, (int)blockIdx.x, (int)gridDim.x);
#endif
#endif
    GSYNC();
    p3_hnorm(a);
    GSYNC();
    { pg8::EpiResid E{nullptr, XB, SS + SSN};     run_gemm(L, (const bf16u*)(ws + WS_HN), (const bf16u*)(ws + WS_WOUT), 2048, 2048, E); }
    GSYNC();
    { pg8::EpiConvAct E{(bf16u*)(ws + WS_ACT), (bf16u*)(ws + WS_U), SS + SSN, (const float*)a.in[20], (const float*)a.in[21]}; run_gemm(L, XB, (const bf16u*)(ws + WS_WUP0), 11264, 2048, E); }
    if ((int)gridDim.x == 256 && (int)blockIdx.x >= 128) { const int t_ = ltid(); convert_weights(a, CW_EARLY, CW_EARLY + CW_I7, ((int)blockIdx.x - 128) * NWAVES + (t_ >> 6), 128 * NWAVES, t_ & 63); }
    else if ((int)gridDim.x != 256) { const int t_ = ltid(); convert_weights(a, CW_EARLY, CW_ALL, (int)blockIdx.x * NWAVES + (t_ >> 6), (int)gridDim.x * NWAVES, t_ & 63); }
    GSYNC();
#ifndef NO_FIX
    p_convfix(a, 0);
#endif
    GSYNC();
    { pg8::EpiResid E{nullptr, XB, SS + 2 * SSN}; run_gemm(L, (const bf16u*)(ws + WS_ACT), (const bf16u*)(ws + WS_WDN0), 2048, 5632, E); }
    GSYNC();
    { pg8::EpiQKV E{(bf16u*)(ws + WS_QH), SS + 2 * SSN, (const float*)(ws + WS_COS), (const float*)(ws + WS_SIN)}; run_gemm(L, XB, (const bf16u*)(ws + WS_WQKV), 6144, 2048, E); }
    GSYNC();
#ifndef NO_ATT
    p_attention(a, (char*)lds);
#ifdef DUP_ATT
    __syncthreads(); p_attention(a, (char*)lds);
#endif
#endif
    GSYNC();
    p_diffnorm(a);
    GSYNC();
    { pg8::EpiResid E{nullptr, XB, SS + 3 * SSN}; run_gemm(L, (const bf16u*)(ws + WS_ON), (const bf16u*)(ws + WS_WO), 2048, 2048, E); }
    GSYNC();
    { pg8::EpiConvAct E{(bf16u*)(ws + WS_ACT), (bf16u*)(ws + WS_U), SS + 3 * SSN, (const float*)a.in[20] + 3 * 11264, (const float*)a.in[21] + 11264}; run_gemm(L, XB, (const bf16u*)(ws + WS_WUP1), 11264, 2048, E); }
    GSYNC();
#ifndef NO_FIX
    p_convfix(a, 1);
#endif
    GSYNC();
    { pg8::EpiResid E{nullptr, XB, SS}; run_gemm(L, (const bf16u*)(ws + WS_ACT), (const bf16u*)(ws + WS_WDN1), 2048, 5632, E); }
    GSYNC();
    p_final(a);
}

extern "C" void kernel_launch(void* const* d_in, const int* in_sizes, int n_in, void* d_out, int out_size, void* d_ws, size_t ws_size, hipStream_t stream) {
    static int grid = 0;
    if (grid == 0) {
        if (n_in != 24 || out_size != MTOK * DM || ws_size < WS_END) { fprintf(stderr, "kernel_launch: unexpected shapes (n_in %d out %d ws %zu)\n", n_in, out_size, ws_size); grid = -1; return; }
        int dev = 0, cus = 0, per_cu = 0;
        (void)hipGetDevice(&dev); (void)hipDeviceGetAttribute(&cus, hipDeviceAttributeMultiprocessorCount, dev);
        if (hipFuncSetAttribute((const void*)fwd_megakernel, hipFuncAttributeMaxDynamicSharedMemorySize, LDS_BYTES) != hipSuccess) fprintf(stderr, "kernel_launch: hipFuncSetAttribute failed\n");
        if (hipOccupancyMaxActiveBlocksPerMultiprocessor(&per_cu, (const void*)fwd_megakernel, 512, LDS_BYTES) != hipSuccess || per_cu < 1) { fprintf(stderr, "kernel_launch: occupancy query says %d\n", per_cu); per_cu = 1; }
        (void)hipGetLastError();
        if (cus <= 0) cus = 256;
        grid = cus;
    }
    if (grid < 0) return;
    Args a{};
    for (int i = 0; i < 24; ++i) a.in[i] = d_in[i];
    a.out = (float*)d_out; a.ws = (unsigned char*)d_ws;
    for (int i = 0; i < 16; ++i) a.invf[i] = (float)pow(500000.0, -(double)i / 16.0);
    (void)hipMemsetAsync((unsigned char*)d_ws + WS_BAR, 0, 16384, stream);
    void* args[] = {&a};
    hipError_t e = hipLaunchCooperativeKernel((const void*)fwd_megakernel, dim3(grid), dim3(512), args, LDS_BYTES, stream);
    if (e != hipSuccess) fprintf(stderr, "kernel_launch: cooperative launch failed: %s (grid %d)\n", hipGetErrorString(e), grid);
}
```
